# Optimizing an MI355X kernel written in HIP

```python
import math
import jax, jax.numpy as jnp
from jax import lax
import numpy as np

D_MODEL = 1024
BATCH = 4
SEQ = 8192
DEPTH = 1

HEAD_DIM = 64
SB_HEADS = 6
MOBA_HEADS = 6
MEM_HEADS = 4
MEM_LEN = 256
SB_W = SB_HEADS * HEAD_DIM
MOBA_W = MOBA_HEADS * HEAD_DIM
MEM_W = MEM_HEADS * HEAD_DIM
SB_QBLOCK = 128
MOBA_BLOCK = 256
MOBA_TOPK = 3
MOBA_QCHUNK = 32
ROPE_THETA = 10000.0
D_FF = -(-8 * D_MODEL // (3 * 256)) * 256
N_BRANCH = 3
EPS = 1e-6
IN_SPLIT_SIZES = (SB_W, SB_W, SB_W, MOBA_W, MOBA_W, MOBA_W, MEM_W, D_MODEL, D_MODEL, D_MODEL)
IN_WIDTH = sum(IN_SPLIT_SIZES)

kernel_name = "hybrid_stickbreak_moba_memory_swiglu"


def rms_norm(x, g):
    xf = x.astype(jnp.float32)
    y = xf * lax.rsqrt(jnp.mean(xf * xf, axis=-1, keepdims=True) + EPS)
    return (y * g.astype(jnp.float32)).astype(x.dtype)


def head_rms(t, g):
    return t * lax.rsqrt(jnp.mean(t * t, axis=-1, keepdims=True) + EPS) * g.astype(jnp.float32)


def split_heads(t, n):
    b, s, _ = t.shape
    return t.reshape(b, s, n, HEAD_DIM).transpose(0, 2, 1, 3).astype(jnp.float32)


def merge_heads(t):
    b, h, s, d = t.shape
    return t.transpose(0, 2, 1, 3).reshape(b, s, h * d)


def rope(t, pos):
    half = HEAD_DIM // 2
    inv_freq = ROPE_THETA ** (-jnp.arange(half, dtype=jnp.float32) * 2.0 / HEAD_DIM)
    ang = pos[:, None] * inv_freq[None, :]
    cos, sin = jnp.cos(ang), jnp.sin(ang)
    t1, t2 = t[..., :half], t[..., half:]
    return jnp.concatenate([t1 * cos - t2 * sin, t2 * cos + t1 * sin], axis=-1)


def stick_breaking_attention(q, k, v):
    b, h, s, d = q.shape
    nqb = s // SB_QBLOCK
    scale = 1.0 / math.sqrt(d)
    qb = q.reshape(b, h, nqb, SB_QBLOCK, d).transpose(2, 0, 1, 3, 4)
    kpos = jnp.arange(s)

    def block(args):
        qi, i = args
        qpos = i * SB_QBLOCK + jnp.arange(SB_QBLOCK)
        z = jnp.einsum('bhqd,bhkd->bhqk', qi, k) * scale
        mask = kpos[None, :] < qpos[:, None]
        log_beta = jax.nn.log_sigmoid(z)
        log_1m = jnp.where(mask, jax.nn.log_sigmoid(-z), 0.0)
        tail = lax.cumsum(log_1m, axis=3, reverse=True) - log_1m
        a = jnp.where(mask, jnp.exp(log_beta + tail), 0.0)
        return jnp.einsum('bhqk,bhkd->bhqd', a, v)

    out = lax.map(block, (qb, jnp.arange(nqb)))
    return out.transpose(1, 2, 0, 3, 4).reshape(b, h, s, d)


def moba_attention(q, k, v):
    b, h, s, d = q.shape
    scale = 1.0 / math.sqrt(d)
    sp = -(-s // MOBA_BLOCK) * MOBA_BLOCK
    pad = ((0, 0), (0, 0), (0, sp - s), (0, 0))
    q, k, v = jnp.pad(q, pad), jnp.pad(k, pad), jnp.pad(v, pad)
    nb = sp // MOBA_BLOCK
    kb = k.reshape(b, h, nb, MOBA_BLOCK, d)
    vb = v.reshape(b, h, nb, MOBA_BLOCK, d)
    kmean = jnp.mean(kb, axis=3)
    pos = jnp.arange(sp)
    qblk = pos // MOBA_BLOCK
    gate = jnp.einsum('bhtd,bhnd->bhtn', q, kmean)
    past = jnp.arange(nb)[None, :] < qblk[:, None]
    gate = jnp.where(past, gate, -jnp.inf)
    topk = min(MOBA_TOPK, nb)
    _, sel = lax.top_k(gate, topk)
    sel_ok = jnp.arange(topk)[None, :] < qblk[:, None]

    nc = sp // MOBA_QCHUNK
    qc = q.reshape(b, h, nc, MOBA_QCHUNK, d).transpose(2, 0, 1, 3, 4)
    selc = sel.reshape(b, h, nc, MOBA_QCHUNK, topk).transpose(2, 0, 1, 3, 4)
    okc = sel_ok.reshape(nc, MOBA_QCHUNK, topk)
    gather = jax.vmap(jax.vmap(lambda blocks, idx: blocks[idx]))

    def chunk(args):
        qi, si, oki, c = args
        qpos = c * MOBA_QCHUNK + jnp.arange(MOBA_QCHUNK)
        own = (c * MOBA_QCHUNK) // MOBA_BLOCK
        k_own = lax.dynamic_index_in_dim(kb, own, axis=2, keepdims=False)
        v_own = lax.dynamic_index_in_dim(vb, own, axis=2, keepdims=False)
        k_sel = gather(kb, si)
        v_sel = gather(vb, si)
        s_sel = jnp.einsum('bhqd,bhqnkd->bhqnk', qi, k_sel) * scale
        s_sel = jnp.where(oki[None, None, :, :, None], s_sel, -jnp.inf)
        s_sel = s_sel.reshape(b, h, MOBA_QCHUNK, topk * MOBA_BLOCK)
        s_own = jnp.einsum('bhqd,bhkd->bhqk', qi, k_own) * scale
        kpos_own = own * MOBA_BLOCK + jnp.arange(MOBA_BLOCK)
        s_own = jnp.where(kpos_own[None, :] <= qpos[:, None], s_own, -jnp.inf)
        p = jax.nn.softmax(jnp.concatenate([s_sel, s_own], axis=-1), axis=-1)
        p_sel = p[..., :topk * MOBA_BLOCK].reshape(b, h, MOBA_QCHUNK, topk, MOBA_BLOCK)
        p_own = p[..., topk * MOBA_BLOCK:]
        return (jnp.einsum('bhqnk,bhqnkd->bhqd', p_sel, v_sel)
                + jnp.einsum('bhqk,bhkd->bhqd', p_own, v_own))

    out = lax.map(chunk, (qc, selc, okc, jnp.arange(nc)))
    out = out.transpose(1, 2, 0, 3, 4).reshape(b, h, sp, d)
    return out[:, :, :s]


def memory_cross_attention(q, k, v):
    scale = 1.0 / math.sqrt(q.shape[-1])
    p = jax.nn.softmax(jnp.einsum('bhsd,bhmd->bhsm', q, k) * scale, axis=-1)
    return jnp.einsum('bhsm,bhmd->bhsd', p, v)


def hybrid_layer(x, mem, mix_norm_g, mem_norm_g, ffn_norm_g, w_in, w_mem_kv,
                 moba_q_norm_g, moba_k_norm_g, mem_q_norm_g, mem_k_norm_g,
                 w_up_sb, w_up_moba, w_up_mem, w_out, w_ffn_in, w_ffn_down):
    s = x.shape[1]
    pos = jnp.arange(s, dtype=jnp.float32)
    h = rms_norm(x, mix_norm_g)
    proj = h @ w_in
    offsets = list(np.cumsum(IN_SPLIT_SIZES)[:-1].tolist())
    (sb_q, sb_k, sb_v, mo_q, mo_k, mo_v, me_q, g_sb, g_mo, g_me) = jnp.split(proj, offsets, axis=-1)

    o_sb = stick_breaking_attention(split_heads(sb_q, SB_HEADS), split_heads(sb_k, SB_HEADS),
                                    split_heads(sb_v, SB_HEADS))
    mq = rope(head_rms(split_heads(mo_q, MOBA_HEADS), moba_q_norm_g), pos)
    mk = rope(head_rms(split_heads(mo_k, MOBA_HEADS), moba_k_norm_g), pos)
    o_mo = moba_attention(mq, mk, split_heads(mo_v, MOBA_HEADS))
    mem_h = rms_norm(mem, mem_norm_g)
    mem_k, mem_v = jnp.split(mem_h @ w_mem_kv, 2, axis=-1)
    cq = head_rms(split_heads(me_q, MEM_HEADS), mem_q_norm_g)
    ck = head_rms(split_heads(mem_k, MEM_HEADS), mem_k_norm_g)
    o_me = memory_cross_attention(cq, ck, split_heads(mem_v, MEM_HEADS))

    dt = x.dtype
    up_sb = (merge_heads(o_sb).astype(dt) @ w_up_sb).astype(jnp.float32)
    up_mo = (merge_heads(o_mo).astype(dt) @ w_up_moba).astype(jnp.float32)
    up_me = (merge_heads(o_me).astype(dt) @ w_up_mem).astype(jnp.float32)
    mix = (jax.nn.sigmoid(g_sb.astype(jnp.float32)) * up_sb
           + jax.nn.sigmoid(g_mo.astype(jnp.float32)) * up_mo
           + jax.nn.sigmoid(g_me.astype(jnp.float32)) * up_me)
    x = x + (mix.astype(dt) @ w_out).astype(dt)

    h2 = rms_norm(x, ffn_norm_g)
    gate, up = jnp.split(h2 @ w_ffn_in, 2, axis=-1)
    ff = (jax.nn.silu(gate.astype(jnp.float32)) * up.astype(jnp.float32)).astype(dt)
    return x + (ff @ w_ffn_down).astype(dt)


def setup_inputs(seed: int = 0) -> dict:
    key = jax.random.key(seed)
    ks = jax.random.split(key, 20)
    f32 = jnp.float32

    def w(k, shape, fan_in):
        return jax.random.normal(k, shape, f32) * (fan_in ** -0.5)

    def gain(k, shape):
        return 1.0 + 0.02 * jax.random.normal(k, shape, f32)

    L = DEPTH
    return {
        "x": jax.random.normal(ks[0], (BATCH, SEQ, D_MODEL), f32),
        "mem": jax.random.normal(ks[1], (BATCH, MEM_LEN, D_MODEL), f32),
        "mix_norm_g": gain(ks[2], (L, D_MODEL)),
        "mem_norm_g": gain(ks[3], (L, D_MODEL)),
        "ffn_norm_g": gain(ks[4], (L, D_MODEL)),
        "w_in": w(ks[5], (L, D_MODEL, IN_WIDTH), D_MODEL),
        "w_mem_kv": w(ks[6], (L, D_MODEL, 2 * MEM_W), D_MODEL),
        "moba_q_norm_g": gain(ks[7], (L, HEAD_DIM)),
        "moba_k_norm_g": gain(ks[8], (L, HEAD_DIM)),
        "mem_q_norm_g": gain(ks[9], (L, HEAD_DIM)),
        "mem_k_norm_g": gain(ks[10], (L, HEAD_DIM)),
        "w_up_sb": w(ks[11], (L, SB_W, D_MODEL), SB_W),
        "w_up_moba": w(ks[12], (L, MOBA_W, D_MODEL), MOBA_W),
        "w_up_mem": w(ks[13], (L, MEM_W, D_MODEL), MEM_W),
        "w_out": w(ks[14], (L, D_MODEL, D_MODEL), D_MODEL),
        "w_ffn_in": w(ks[15], (L, D_MODEL, 2 * D_FF), D_MODEL),
        "w_ffn_down": w(ks[16], (L, D_FF, D_MODEL), D_FF),
    }


def reference(x, mem, mix_norm_g, mem_norm_g, ffn_norm_g, w_in, w_mem_kv,
              moba_q_norm_g, moba_k_norm_g, mem_q_norm_g, mem_k_norm_g,
              w_up_sb, w_up_moba, w_up_mem, w_out, w_ffn_in, w_ffn_down):
    for l in range(DEPTH):
        x = hybrid_layer(x, mem, mix_norm_g[l], mem_norm_g[l], ffn_norm_g[l], w_in[l], w_mem_kv[l],
                         moba_q_norm_g[l], moba_k_norm_g[l], mem_q_norm_g[l], mem_k_norm_g[l],
                         w_up_sb[l], w_up_moba[l], w_up_mem[l], w_out[l], w_ffn_in[l], w_ffn_down[l])
    return x
```

```cpp
#include <hip/hip_runtime.h>
#include <hip/hip_cooperative_groups.h>
#include <cstdio>
#include <cstdint>
namespace cg = cooperative_groups;
namespace pg8 {
#define PG8_LAS __attribute__((address_space(3)))
typedef unsigned short bf16_t;
typedef short bf16x8 __attribute__((ext_vector_type(8)));
typedef float f32x4 __attribute__((ext_vector_type(4)));
typedef unsigned u32x4 __attribute__((ext_vector_type(4)));
constexpr int BM = 256, BK = 64, HALF = 128, HTB = HALF * BK * 2  , STAGE_BYTES = 8 * HTB, NXCD = 8, WGM = 8;

__host__ __device__ __forceinline__ int lds_byte(int r, int c) { const int st = (r >> 4) * 2 + (c >> 5), rr = r & 15, cc = c & 31, ob = rr * 64 + cc * 2; return st * 1024 + (ob ^ (((ob >> 9) & 1) << 5)); }
__host__ __device__ __forceinline__ void stage_rc(int b, int& R, int& C) { const int st = b / 1024, sb = b % 1024, swz = sb ^ (((sb >> 9) & 1) << 5); R = (st >> 1) * 16 + swz / 64; C = (st & 1) * 32 + (swz % 64) / 2; }
__host__ __device__ __forceinline__ int perm32(int rho) { const int n = rho >> 4, i = rho & 15; return 8 * (i >> 2) + 4 * n + (i & 3); }

struct Unit { int pm, pn; };
struct Gemm { const bf16_t* A; const bf16_t* Bt; int M, N, K, lda; };

struct StaticOrder {
    int nM, nN, nwg, G, c;
    __host__ __device__ void init(int M, int N, int G_, int c_) { nM = M / BM; nN = N / BM; nwg = nM * nN; G = G_; c = c_; }
    __host__ __device__ bool next(int i, Unit& u) const {
        const long L = (long)i * G + c; if (L >= nwg) return false;
        int wgid = (int)L; { const int q = nwg / NXCD, r = nwg % NXCD, xcd = wgid % NXCD, off = wgid / NXCD; wgid = (xcd < r ? xcd * (q + 1) : r * (q + 1) + (xcd - r) * q) + off; }
        const int nig = WGM * nN, gid = wgid / nig, fm = gid * WGM, gsz = (nM - fm) < WGM ? (nM - fm) : WGM;
        u.pm = fm + ((wgid % nig) % gsz); u.pn = (wgid % nig) / gsz; return true;
    }
    __device__ __forceinline__ void a_ready(const Unit&) const {}
    __device__ __forceinline__ void done(const Unit&) const {}
};

typedef __bf16 bf16v2_t __attribute__((ext_vector_type(2)));
typedef float f32v2_t __attribute__((ext_vector_type(2)));
__device__ __forceinline__ unsigned cvt_pk_bf16(float lo, float hi) { const f32v2_t v = {lo, hi}; const bf16v2_t b = __builtin_convertvector(v, bf16v2_t); return __builtin_bit_cast(unsigned, b); }
typedef float f32x2 __attribute__((ext_vector_type(2)));

typedef unsigned u32x2 __attribute__((ext_vector_type(2)));
__device__ __forceinline__ float bf_lo(unsigned u) { return __uint_as_float(u << 16); }
__device__ __forceinline__ float bf_hi(unsigned u) { return __uint_as_float(u & 0xffff0000u); }
__device__ __forceinline__ float sigmoidf_(float v) { return __builtin_amdgcn_rcpf(1.0f + __builtin_amdgcn_exp2f(-1.4426950408889634f * v)); }

struct EpiProj {
    static constexpr bool PERM = true, AFTER_DRAIN = false;
    bf16_t* QKV; bf16_t* GATES;
    __device__ __forceinline__ void operator()(const f32x4 (&acc)[2][2][4][2], const Unit& u, int wr, int wc, int fr, int fq) const {
        const int row0 = u.pm * BM + wr * 64 + fr;
        const bool isg = u.pn >= 10;
        bf16_t* base = isg ? GATES : QKV; const int ldc = isg ? 3072 : 2560; const int colt = isg ? (u.pn - 10) * BM : u.pn * BM;
        const int col0 = colt + wc * 32 + 8 * fq;
#pragma unroll
        for (int ai = 0; ai < 2; ++ai)
#pragma unroll
            for (int m = 0; m < 4; ++m) { bf16_t* rowp = base + (size_t)(row0 + ai * HALF + m * 16) * ldc + col0;
#pragma unroll
                for (int bj = 0; bj < 2; ++bj) { f32x4 v0 = acc[ai][bj][m][0], v1 = acc[ai][bj][m][1];
                    if (isg) {
#pragma unroll
                        for (int e = 0; e < 4; ++e) { v0[e] = sigmoidf_(v0[e]); v1[e] = sigmoidf_(v1[e]); } }
                    u32x4 w; w.x = cvt_pk_bf16(v0[0], v0[1]); w.y = cvt_pk_bf16(v0[2], v0[3]); w.z = cvt_pk_bf16(v1[0], v1[1]); w.w = cvt_pk_bf16(v1[2], v1[3]);
                    *(u32x4*)(rowp + bj * HALF) = w; } }
    }
};
struct EpiPlain {
    static constexpr bool PERM = true, AFTER_DRAIN = false;
    bf16_t* O; int ldc;
    __device__ __forceinline__ void operator()(const f32x4 (&acc)[2][2][4][2], const Unit& u, int wr, int wc, int fr, int fq) const {
        const int row0 = u.pm * BM + wr * 64 + fr; const int col0 = u.pn * BM + wc * 32 + 8 * fq;
#pragma unroll
        for (int ai = 0; ai < 2; ++ai)
#pragma unroll
            for (int m = 0; m < 4; ++m) { bf16_t* rowp = O + (size_t)(row0 + ai * HALF + m * 16) * ldc + col0;
#pragma unroll
                for (int bj = 0; bj < 2; ++bj) { const f32x4 v0 = acc[ai][bj][m][0], v1 = acc[ai][bj][m][1];
                    u32x4 w; w.x = cvt_pk_bf16(v0[0], v0[1]); w.y = cvt_pk_bf16(v0[2], v0[3]); w.z = cvt_pk_bf16(v1[0], v1[1]); w.w = cvt_pk_bf16(v1[2], v1[3]);
                    *(u32x4*)(rowp + bj * HALF) = w; } }
    }
};
template <bool FIRST> struct EpiGate {
    static constexpr bool PERM = true, AFTER_DRAIN = false;
    bf16_t* MIX; const bf16_t* GATES; int goff;
    __device__ __forceinline__ void operator()(const f32x4 (&acc)[2][2][4][2], const Unit& u, int wr, int wc, int fr, int fq) const {
        const unsigned row0 = u.pm * BM + wr * 64 + fr; const unsigned col0 = u.pn * BM + wc * 32 + 8 * fq;
        const char* gb = (const char*)(GATES + goff); char* mb = (char*)MIX;
#pragma unroll
        for (int ai = 0; ai < 2; ++ai)
#pragma unroll
            for (int m = 0; m < 4; ++m) { const unsigned row = row0 + ai * HALF + m * 16;
#pragma unroll
                for (int bj = 0; bj < 2; ++bj) { const f32x4 v0 = acc[ai][bj][m][0], v1 = acc[ai][bj][m][1];
                    const unsigned goffb = (row * 3072u + col0 + bj * HALF) * 2u, moffb = (row * 1024u + col0 + bj * HALF) * 2u;
                    const u32x4 gt = *(const u32x4*)(gb + goffb);
                    float r[8];
                    r[0] = v0[0] * bf_lo(gt.x); r[1] = v0[1] * bf_hi(gt.x); r[2] = v0[2] * bf_lo(gt.y); r[3] = v0[3] * bf_hi(gt.y);
                    r[4] = v1[0] * bf_lo(gt.z); r[5] = v1[1] * bf_hi(gt.z); r[6] = v1[2] * bf_lo(gt.w); r[7] = v1[3] * bf_hi(gt.w);
                    if (!FIRST) { const u32x4 pv = *(const u32x4*)(mb + moffb);
                        r[0] += bf_lo(pv.x); r[1] += bf_hi(pv.x); r[2] += bf_lo(pv.y); r[3] += bf_hi(pv.y); r[4] += bf_lo(pv.z); r[5] += bf_hi(pv.z); r[6] += bf_lo(pv.w); r[7] += bf_hi(pv.w); }
                    u32x4 w; w.x = cvt_pk_bf16(r[0], r[1]); w.y = cvt_pk_bf16(r[2], r[3]); w.z = cvt_pk_bf16(r[4], r[5]); w.w = cvt_pk_bf16(r[6], r[7]);
                    *(u32x4*)(mb + moffb) = w;
                    asm volatile("" ::: "memory"); } }
    }
};
struct EpiRes1 {
    static constexpr bool PERM = true, AFTER_DRAIN = false;
    const float* X; float* OUT; bf16_t* X1B; float* SS;
    __device__ __forceinline__ void operator()(const f32x4 (&acc)[2][2][4][2], const Unit& u, int wr, int wc, int fr, int fq) const {
        const int row0 = u.pm * BM + wr * 64 + fr; const int col0 = u.pn * BM + wc * 32 + 8 * fq;
#pragma unroll
        for (int ai = 0; ai < 2; ++ai)
#pragma unroll
            for (int m = 0; m < 4; ++m) { const size_t row = (size_t)(row0 + ai * HALF + m * 16); float ss = 0.f;
#pragma unroll
                for (int bj = 0; bj < 2; ++bj) { const size_t off = row * 1024 + col0 + bj * HALF;
                    const f32x4 x0 = *(const f32x4*)(X + off), x1 = *(const f32x4*)(X + off + 4);
                    const f32x4 v0 = acc[ai][bj][m][0] + x0, v1 = acc[ai][bj][m][1] + x1;
                    *(f32x4*)(OUT + off) = v0; *(f32x4*)(OUT + off + 4) = v1;
                    ss += (v0[0] * v0[0] + v0[1] * v0[1]) + (v0[2] * v0[2] + v0[3] * v0[3]) + (v1[0] * v1[0] + v1[1] * v1[1]) + (v1[2] * v1[2] + v1[3] * v1[3]);
                    u32x4 w; w.x = cvt_pk_bf16(v0[0], v0[1]); w.y = cvt_pk_bf16(v0[2], v0[3]); w.z = cvt_pk_bf16(v1[0], v1[1]); w.w = cvt_pk_bf16(v1[2], v1[3]);
                    *(u32x4*)(X1B + off) = w; }
                ss += __shfl_xor(ss, 16); ss += __shfl_xor(ss, 32);
                if (fq == 0) __hip_atomic_fetch_add(SS + row, ss, __ATOMIC_RELAXED, __HIP_MEMORY_SCOPE_AGENT);
                asm volatile("" ::: "memory"); }
    }
};
struct EpiSwiGLU {
    static constexpr bool PERM = true, AFTER_DRAIN = false;
    bf16_t* HB; const float* SS;
    __device__ __forceinline__ void operator()(const f32x4 (&acc)[2][2][4][2], const Unit& u, int wr, int wc, int fr, int fq) const {
        const int row0 = u.pm * BM + wr * 64 + fr; const int col0 = u.pn * HALF + wc * 32 + 8 * fq;
#pragma unroll
        for (int ai = 0; ai < 2; ++ai)
#pragma unroll
            for (int m = 0; m < 4; ++m) { const size_t row = (size_t)(row0 + ai * HALF + m * 16);
                const float rstd = __builtin_amdgcn_rsqf(SS[row] * (1.0f / 1024.0f) + 1e-6f);
                float r[8];
#pragma unroll
                for (int n = 0; n < 2; ++n)
#pragma unroll
                    for (int e = 0; e < 4; ++e) { const float gt = acc[ai][0][m][n][e] * rstd, up = acc[ai][1][m][n][e] * rstd; r[4 * n + e] = gt * sigmoidf_(gt) * up; }
                u32x4 w; w.x = cvt_pk_bf16(r[0], r[1]); w.y = cvt_pk_bf16(r[2], r[3]); w.z = cvt_pk_bf16(r[4], r[5]); w.w = cvt_pk_bf16(r[6], r[7]);
                *(u32x4*)(HB + row * 2816 + col0) = w; }
    }
};
struct EpiRes2 {
    static constexpr bool PERM = true, AFTER_DRAIN = false;
    float* OUT;
    __device__ __forceinline__ void operator()(const f32x4 (&acc)[2][2][4][2], const Unit& u, int wr, int wc, int fr, int fq) const {
        const int row0 = u.pm * BM + wr * 64 + fr; const int col0 = u.pn * BM + wc * 32 + 8 * fq;
#pragma unroll
        for (int ai = 0; ai < 2; ++ai)
#pragma unroll
            for (int m = 0; m < 4; ++m) { const size_t row = (size_t)(row0 + ai * HALF + m * 16);
#pragma unroll
                for (int bj = 0; bj < 2; ++bj) { const size_t off = row * 1024 + col0 + bj * HALF;
                    const f32x4 x0 = *(const f32x4*)(OUT + off), x1 = *(const f32x4*)(OUT + off + 4);
                    *(f32x4*)(OUT + off) = acc[ai][bj][m][0] + x0; *(f32x4*)(OUT + off + 4) = acc[ai][bj][m][1] + x1; }
                asm volatile("" ::: "memory"); }
    }
};
template <class Epi, class Sched, bool ALIGN_EPI = false, bool SP2 = false>
__device__ __forceinline__ void gemm_phase(PG8_LAS unsigned char* lds, const Gemm g, const Sched& S, const Epi& E) {
    const int tid = threadIdx.x, wid = __builtin_amdgcn_readfirstlane(tid >> 6), lane = tid & 63, wr = wid >> 2, wc = wid & 3, fr = lane & 15, fq = lane >> 4;
    const int K = g.K, nt = K / BK;
    unsigned voffA[2], voffB[2];
#pragma unroll
    for (int i = 0; i < 2; ++i) { int R, C; stage_rc(tid * 16 + i * 8192, R, C); const int Rb = Epi::PERM ? ((R & ~31) + perm32(R & 31)) : R;
        voffA[i] = (unsigned)(R * g.lda + C) * 2u; voffB[i] = (unsigned)(Rb * K + C) * 2u; }
    const size_t kstep = (size_t)(BK * 2);
    const size_t hstep = (size_t)HALF * K * 2, hstepA = (size_t)HALF * g.lda * 2;
    const size_t tstep = 2 * hstep, tstepA = 2 * hstepA;
    const unsigned ldsw = (unsigned)wid * 1024u;
    const int aoff = lds_byte(wr * 64 + fr, fq * 8), boff = lds_byte(wc * 32 + fr, fq * 8);
#define PG8_SA(b, h) (((b) * 2 + (h)) * HTB)
#define PG8_SB(b, h) ((4 + (b) * 2 + (h)) * HTB)
#define PG8_STAGE(bufoff, gbase, voff) do { _Pragma("unroll") for (int _i = 0; _i < 2; ++_i) \
        __builtin_amdgcn_global_load_lds((const unsigned*)((const char*)(gbase) + (voff)[_i]), (PG8_LAS unsigned*)(lds + (bufoff) + ldsw + _i * 8192), 16, 0, 0); } while (0)
#define PG8_LDA(dst, b, h) do { _Pragma("unroll") for (int m = 0; m < 4; ++m) _Pragma("unroll") for (int k = 0; k < 2; ++k) dst[m][k] = *(const PG8_LAS bf16x8*)(lds + PG8_SA(b, h) + aoff + m * 2048 + k * 1024); } while (0)
#define PG8_LDB(dst, b, h) do { _Pragma("unroll") for (int n = 0; n < 2; ++n) _Pragma("unroll") for (int k = 0; k < 2; ++k) dst[n][k] = *(const PG8_LAS bf16x8*)(lds + PG8_SB(b, h) + boff + n * 2048 + k * 1024); } while (0)
#define PG8_MMA(ai, bj, At, Bt) do { __builtin_amdgcn_s_setprio(1); _Pragma("unroll") for (int m = 0; m < 4; ++m) _Pragma("unroll") for (int n = 0; n < 2; ++n) _Pragma("unroll") for (int k = 0; k < 2; ++k) \
        acc[ai][bj][m][n] = __builtin_amdgcn_mfma_f32_16x16x32_bf16(Bt[n][k], At[m][k], acc[ai][bj][m][n], 0, 0, 0); __builtin_amdgcn_s_setprio(0); } while (0)
#define PG8_WAIT_V(n) asm volatile("s_waitcnt vmcnt(" #n ")" ::: "memory")
#define PG8_WAIT_L(n) asm volatile("s_waitcnt lgkmcnt(" #n ")" ::: "memory")
#define PG8_BAR __builtin_amdgcn_s_barrier()
#define PG8_SCHED __builtin_amdgcn_sched_barrier(0)
    Unit cur, nxt; int ui = 0;
    if (!S.next(0, cur)) return;
    f32x4 acc[2][2][4][2];
#pragma unroll
    for (int a = 0; a < 2; ++a)
#pragma unroll
        for (int b = 0; b < 2; ++b)
#pragma unroll
            for (int m = 0; m < 4; ++m)
#pragma unroll
                for (int n = 0; n < 2; ++n) acc[a][b][m][n] = (f32x4){0.f, 0.f, 0.f, 0.f};
    bf16x8 At[4][2], B0[2][2], B1[2][2];
    const char* cA = (const char*)g.A + (size_t)cur.pm * tstepA; const char* cB = (const char*)g.Bt + (size_t)cur.pn * tstep;
    S.a_ready(cur);
    if constexpr (SP2) {
        PG8_STAGE(PG8_SB(0, 0), cB, voffB); PG8_STAGE(PG8_SB(0, 1), cB + hstep, voffB); PG8_STAGE(PG8_SA(0, 0), cA, voffA); PG8_STAGE(PG8_SA(0, 1), cA + hstepA, voffA);
        if (wr == 1) PG8_BAR;
        PG8_WAIT_V(2); PG8_BAR;
        PG8_STAGE(PG8_SB(1, 0), cB + kstep, voffB); PG8_STAGE(PG8_SA(1, 0), cA + kstep, voffA); PG8_STAGE(PG8_SB(1, 1), cB + hstep + kstep, voffB);
        PG8_WAIT_V(6); PG8_BAR;
    } else {
        PG8_STAGE(PG8_SB(0, 0), cB, voffB); PG8_STAGE(PG8_SA(0, 0), cA, voffA); PG8_STAGE(PG8_SB(0, 1), cB + hstep, voffB); PG8_STAGE(PG8_SA(0, 1), cA + hstepA, voffA);
        if (wr == 1) PG8_BAR;
        PG8_WAIT_V(4); PG8_BAR;
        PG8_STAGE(PG8_SB(1, 0), cB + kstep, voffB); PG8_STAGE(PG8_SA(1, 0), cA + kstep, voffA); PG8_STAGE(PG8_SB(1, 1), cB + hstep + kstep, voffB);
        PG8_WAIT_V(6); PG8_BAR;
    }
    for (;;) {
        const bool has_next = S.next(ui + 1, nxt);
        const char* nA = has_next ? (const char*)g.A + (size_t)nxt.pm * tstepA : cA; const char* nB = has_next ? (const char*)g.Bt + (size_t)nxt.pn * tstep : cB;
#pragma nounroll
        for (int t = 0; t < nt; t += 2) {
            const bool last = (t == nt - 2);
            const char* a1 = cA + (size_t)(t + 1) * kstep;
            const char* a2 = last ? nA : cA + (size_t)(t + 2) * kstep; const char* b2 = last ? nB : cB + (size_t)(t + 2) * kstep;
            const char* a3 = a2 + kstep; const char* b3 = b2 + kstep;
            if (last && has_next) S.a_ready(nxt);
            if constexpr (SP2) {
            PG8_LDB(B0, 0, 0); PG8_LDB(B1, 0, 1); PG8_SCHED; PG8_LDA(At, 0, 0); PG8_STAGE(PG8_SA(1, 1), a1 + hstepA, voffA);
            PG8_WAIT_V(8); PG8_WAIT_L(0); PG8_BAR; PG8_MMA(0, 0, At, B0); PG8_MMA(0, 1, At, B1); PG8_BAR; PG8_SCHED;
            PG8_LDA(At, 0, 1); PG8_STAGE(PG8_SB(0, 0), b2, voffB); PG8_STAGE(PG8_SB(0, 1), b2 + hstep, voffB); PG8_STAGE(PG8_SA(0, 0), a2, voffA);
            PG8_WAIT_V(8); PG8_WAIT_L(0); PG8_BAR; PG8_MMA(1, 0, At, B0); PG8_MMA(1, 1, At, B1); PG8_BAR; PG8_SCHED;
            PG8_LDB(B0, 1, 0); PG8_LDB(B1, 1, 1); PG8_SCHED; PG8_LDA(At, 1, 0); PG8_STAGE(PG8_SA(0, 1), a2 + hstepA, voffA);
            PG8_WAIT_V(8); PG8_WAIT_L(0); PG8_BAR; PG8_MMA(0, 0, At, B0); PG8_MMA(0, 1, At, B1); PG8_BAR; PG8_SCHED;
            PG8_LDA(At, 1, 1); PG8_STAGE(PG8_SB(1, 0), b3, voffB); PG8_STAGE(PG8_SB(1, 1), b3 + hstep, voffB); PG8_STAGE(PG8_SA(1, 0), a3, voffA);
            PG8_WAIT_V(8); PG8_WAIT_L(0); PG8_BAR; PG8_MMA(1, 0, At, B0); PG8_MMA(1, 1, At, B1); PG8_BAR; PG8_SCHED;
            } else {
            PG8_LDB(B0, 0, 0); PG8_SCHED; PG8_LDA(At, 0, 0); PG8_STAGE(PG8_SA(1, 1), a1 + hstepA, voffA);
            PG8_WAIT_L(8); PG8_BAR; PG8_WAIT_L(0); PG8_MMA(0, 0, At, B0); PG8_BAR; PG8_SCHED;
            PG8_LDB(B1, 0, 1); PG8_STAGE(PG8_SB(0, 0), b2, voffB);
            PG8_BAR; PG8_WAIT_L(0); PG8_MMA(0, 1, At, B1); PG8_BAR;
            PG8_LDA(At, 0, 1); PG8_STAGE(PG8_SA(0, 0), a2, voffA);
            PG8_BAR; PG8_WAIT_L(0); PG8_MMA(1, 0, At, B0); PG8_BAR; PG8_SCHED;
            PG8_STAGE(PG8_SB(0, 1), b2 + hstep, voffB);
            PG8_WAIT_V(6); PG8_BAR; PG8_MMA(1, 1, At, B1); PG8_BAR;
            PG8_LDB(B0, 1, 0); PG8_SCHED; PG8_LDA(At, 1, 0); PG8_STAGE(PG8_SA(0, 1), a2 + hstepA, voffA);
            PG8_WAIT_L(8); PG8_BAR; PG8_WAIT_L(0); PG8_MMA(0, 0, At, B0); PG8_BAR; PG8_SCHED;
            PG8_LDB(B1, 1, 1); PG8_STAGE(PG8_SB(1, 0), b3, voffB);
            PG8_BAR; PG8_WAIT_L(0); PG8_MMA(0, 1, At, B1); PG8_BAR;
            PG8_LDA(At, 1, 1); PG8_STAGE(PG8_SA(1, 0), a3, voffA);
            PG8_BAR; PG8_WAIT_L(0); PG8_MMA(1, 0, At, B0); PG8_BAR; PG8_SCHED;
            PG8_STAGE(PG8_SB(1, 1), b3 + hstep, voffB);
            PG8_WAIT_V(6); PG8_BAR; PG8_MMA(1, 1, At, B1); PG8_BAR;
            }
        }
        if constexpr (ALIGN_EPI) { if (wr == 0) PG8_BAR; }
        if constexpr (!Epi::AFTER_DRAIN) { E(acc, cur, wr, wc, fr, fq); S.done(cur); }
        if (!has_next) break;
#pragma unroll
        for (int a = 0; a < 2; ++a)
#pragma unroll
            for (int b = 0; b < 2; ++b)
#pragma unroll
                for (int m = 0; m < 4; ++m)
#pragma unroll
                    for (int n = 0; n < 2; ++n) acc[a][b][m][n] = (f32x4){0.f, 0.f, 0.f, 0.f};
        cur = nxt; cA = nA; cB = nB; ++ui;
        if constexpr (ALIGN_EPI) { if (wr == 1) PG8_BAR; }
    }
    PG8_WAIT_V(0);
    if constexpr (!ALIGN_EPI) { if (wr == 0) PG8_BAR; }
    PG8_BAR;
    if constexpr (Epi::AFTER_DRAIN) { E.fused(acc, cur, wr, wc, fr, fq, lds, wid, lane); S.done(cur); }
#undef PG8_SA
#undef PG8_SB
#undef PG8_STAGE
#undef PG8_LDA
#undef PG8_LDB
#undef PG8_MMA
#undef PG8_WAIT_V
#undef PG8_WAIT_L
#undef PG8_BAR
#undef PG8_SCHED
}
}

#define LAS __attribute__((address_space(3)))
typedef unsigned short bf16_t;
typedef short bf16x8 __attribute__((ext_vector_type(8)));
typedef float f32x4 __attribute__((ext_vector_type(4)));
typedef unsigned u32x4 __attribute__((ext_vector_type(4)));
typedef unsigned u32x2 __attribute__((ext_vector_type(2)));
using pg8::cvt_pk_bf16; using pg8::bf_lo; using pg8::bf_hi;

constexpr int NB = 4, S = 8192, DM = 1024, M = NB * S, INW = 5632, DFF = 2816, MEML = 256;
constexpr int QKVW = 2560, GW = 3072;
constexpr int C_SBQ = 0, C_SBK = 384, C_SBV = 768, C_MOQ = 1152, C_MOK = 1536, C_MOV = 1920, C_MEQ = 2304;
constexpr float EPS = 1e-6f;
constexpr float LOG2E = 1.4426950408889634f;
constexpr float SC2 = LOG2E * 0.125f;

constexpr size_t MiB = (size_t)1 << 20;
constexpr size_t WS_CTL = 0;
constexpr size_t WS_SS = 64 * 1024;
constexpr size_t WS_KMEAN = 256 * 1024;
constexpr size_t WS_MEMN = 1 * MiB;
constexpr size_t WS_MEMKV = 3 * MiB;
constexpr size_t WS_MEMVT = 4 * MiB;
constexpr size_t WS_WMEMKV = 5 * MiB;
constexpr size_t WS_WIN = 6 * MiB;
constexpr size_t WS_WFIN = 17 * MiB;
constexpr size_t WS_WFDN = 28 * MiB;
constexpr size_t WS_WOUT = 34 * MiB;
constexpr size_t WS_WUPSB = 36 * MiB, WS_WUPMO = 37 * MiB, WS_WUPME = 38 * MiB;
constexpr size_t WS_XN = 40 * MiB;
constexpr size_t WS_SBVT = 104 * MiB, WS_MOVT = 128 * MiB;
constexpr size_t WS_QKV = 152 * MiB;
constexpr size_t WS_GATES = 312 * MiB;
constexpr size_t WS_ROPE = 504 * MiB;
constexpr size_t WS_END = 506 * MiB;
constexpr int LDS_BYTES = 156 * 1024;

#ifndef PHMASK
#define PHMASK 255
#endif
struct Params { const float* in[17]; float* out; unsigned char* ws; };

__device__ __forceinline__ float wave_sum(float v) {
#pragma unroll
    for (int o = 1; o < 64; o <<= 1) v += __shfl_xor(v, o);
    return v;
}
#define LDS_WAIT() asm volatile("s_waitcnt lgkmcnt(0)" ::: "memory")

template <int MODE>
__device__ __forceinline__ void p0_transpose_item(const float* W, int K, int N, bf16_t* WT, LAS float* scr, int item, int lane, const float* kscale) {
    const int nblk = N / 32, kb = item / nblk, nb = item % nblk, k0 = 64 * kb, n0 = 32 * nb;
#pragma unroll 8
    for (int i = 0; i < 32; ++i) { const int kk = 2 * i + (lane >> 5); float v = W[(size_t)(k0 + kk) * N + n0 + (lane & 31)]; if (MODE == 1) v *= kscale[k0 + kk]; scr[kk * 33 + (lane & 31)] = v; }
    LDS_WAIT();
    int r0 = n0;
    if (MODE == 1) { if (n0 < DFF) r0 = (n0 >> 7) * 256 + (n0 & 127); else { const int n2 = n0 - DFF; r0 = (n2 >> 7) * 256 + 128 + (n2 & 127); } }
    const int c = lane & 7;
#pragma unroll
    for (int j = 0; j < 4; ++j) { const int n = (lane >> 3) + 8 * j; const LAS float* s = scr + (8 * c) * 33 + n;
        u32x4 o; o.x = cvt_pk_bf16(s[0 * 33], s[1 * 33]); o.y = cvt_pk_bf16(s[2 * 33], s[3 * 33]); o.z = cvt_pk_bf16(s[4 * 33], s[5 * 33]); o.w = cvt_pk_bf16(s[6 * 33], s[7 * 33]);
        *(u32x4*)(WT + (size_t)(r0 + n) * K + k0 + 8 * c) = o; }
    LDS_WAIT();
}
__device__ __forceinline__ void rms_row_to_bf16(const float* xrow, const float* gain, bf16_t* orow, int lane) {
    const f32x4* xr = (const f32x4*)xrow + lane; const f32x4* gr = (const f32x4*)gain + lane;
    f32x4 v[4]; float s = 0.f;
#pragma unroll
    for (int j = 0; j < 4; ++j) { v[j] = xr[64 * j]; s += (v[j].x * v[j].x + v[j].y * v[j].y) + (v[j].z * v[j].z + v[j].w * v[j].w); }
    const float rstd = __builtin_amdgcn_rsqf(wave_sum(s) * (1.f / 1024.f) + EPS);
    u32x2* o8 = (u32x2*)orow + lane;
#pragma unroll
    for (int j = 0; j < 4; ++j) { const f32x4 g = gr[64 * j]; u32x2 w; w.x = cvt_pk_bf16(v[j].x * rstd * g.x, v[j].y * rstd * g.y); w.y = cvt_pk_bf16(v[j].z * rstd * g.z, v[j].w * rstd * g.w); o8[64 * j] = w; }
}
__device__ __forceinline__ void rope_entry(int idx, float2* tab) {
    const double INVF[32] = {1.0, 0.7498942093324559, 0.5623413251903491, 0.4216965034285822, 0.31622776601683794, 0.23713737056616552, 0.1778279410038923, 0.1333521432163324, 0.1, 0.07498942093324558, 0.05623413251903491, 0.042169650342858224, 0.03162277660168379, 0.023713737056616554, 0.01778279410038923, 0.01333521432163324, 0.01, 0.007498942093324558, 0.005623413251903491, 0.004216965034285823, 0.0031622776601683794, 0.0023713737056616554, 0.0017782794100389228, 0.001333521432163324, 0.001, 0.0007498942093324559, 0.0005623413251903491, 0.00042169650342858224, 0.00031622776601683794, 0.00023713737056616554, 0.00017782794100389227, 0.0001333521432163324};
    const int pos = idx >> 5, f = idx & 31;
    double invf = 1.0;
#pragma unroll
    for (int i = 0; i < 32; ++i) invf = (f == i) ? INVF[i] : invf;
    const double ang = (double)pos * invf;
    const double k = __builtin_rint(ang * 0.15915494309189535);
    const double r = __builtin_fma(-k, 6.283185307179586, ang);
    const double h = r * 0.25, h2 = h * h;
    double sn = 1.0 / 6227020800.0; sn = sn * h2 - 1.0 / 39916800.0; sn = sn * h2 + 1.0 / 362880.0; sn = sn * h2 - 1.0 / 5040.0; sn = sn * h2 + 1.0 / 120.0; sn = sn * h2 - 1.0 / 6.0; sn = sn * h2 + 1.0; sn *= h;
    double cs = -1.0 / 87178291200.0; cs = cs * h2 + 1.0 / 479001600.0; cs = cs * h2 - 1.0 / 3628800.0; cs = cs * h2 + 1.0 / 40320.0; cs = cs * h2 - 1.0 / 720.0; cs = cs * h2 + 1.0 / 24.0; cs = cs * h2 - 0.5; cs = cs * h2 + 1.0;
    const double s2 = 2.0 * sn * cs, c2 = 1.0 - 2.0 * sn * sn;
    const double s4 = 2.0 * s2 * c2, c4 = 1.0 - 2.0 * s2 * s2;
    tab[idx] = make_float2((float)c4, (float)s4);
}

__device__ __forceinline__ void head_norm_item(bf16_t* base, int ld, const float* gain, const float2* rope_tab, float* kmean_out, LAS float* red, int tid) {
    const int sub = tid & 7, rl = tid >> 3, lane = tid & 63, wave = tid >> 6;
    float gv[8], accm[8];
#pragma unroll
    for (int i = 0; i < 8; ++i) { gv[i] = gain[sub * 8 + i]; accm[i] = 0.f; }
    for (int pass = 0; pass < 4; ++pass) {
        const int row = pass * 64 + rl;
        bf16_t* ptr = base + (size_t)row * ld + sub * 8;
        const u32x4 raw = *(const u32x4*)ptr;
        float v[8] = {bf_lo(raw.x), bf_hi(raw.x), bf_lo(raw.y), bf_hi(raw.y), bf_lo(raw.z), bf_hi(raw.z), bf_lo(raw.w), bf_hi(raw.w)};
        float ss = 0.f;
#pragma unroll
        for (int i = 0; i < 8; ++i) ss += v[i] * v[i];
        ss += __shfl_xor(ss, 1); ss += __shfl_xor(ss, 2); ss += __shfl_xor(ss, 4);
        const float r = __builtin_amdgcn_rsqf(ss * (1.f / 64.f) + EPS);
#pragma unroll
        for (int i = 0; i < 8; ++i) v[i] = v[i] * r * gv[i];
        if (rope_tab) {
            const float2* t = rope_tab + (size_t)row * 32 + (sub & 3) * 8;
#pragma unroll
            for (int i = 0; i < 8; ++i) { const float pv = __shfl_xor(v[i], 4); const float2 cs = t[i]; v[i] = (sub < 4) ? (v[i] * cs.x - pv * cs.y) : (v[i] * cs.x + pv * cs.y); }
        }
        u32x4 w; w.x = cvt_pk_bf16(v[0], v[1]); w.y = cvt_pk_bf16(v[2], v[3]); w.z = cvt_pk_bf16(v[4], v[5]); w.w = cvt_pk_bf16(v[6], v[7]);
        *(u32x4*)ptr = w;
#pragma unroll
        for (int i = 0; i < 8; ++i) accm[i] += v[i];
    }
    if (kmean_out) {
#pragma unroll
        for (int i = 0; i < 8; ++i) { accm[i] += __shfl_xor(accm[i], 8); accm[i] += __shfl_xor(accm[i], 16); accm[i] += __shfl_xor(accm[i], 32); }
        if (lane < 8) {
#pragma unroll
            for (int i = 0; i < 8; ++i) red[wave * 64 + sub * 8 + i] = accm[i]; }
        __syncthreads();
        if (tid < 64) { float s = 0.f;
#pragma unroll
            for (int w = 0; w < 8; ++w) s += red[w * 64 + tid];
            kmean_out[tid] = s * (1.f / 256.f); }
        __syncthreads();
    }
}
__device__ __forceinline__ void transpose_item256(const bf16_t* src, int ld, bf16_t* dst, size_t dpitch, LAS unsigned short* tile, int tid) {
#pragma unroll
    for (int pass = 0; pass < 4; ++pass) { const int row = pass * 64 + (tid >> 3), sub = tid & 7;
        const u32x4 raw = *(const u32x4*)(src + (size_t)row * ld + sub * 8);
        LAS unsigned* t32 = (LAS unsigned*)(tile + row * 66 + sub * 8); t32[0] = raw.x; t32[1] = raw.y; t32[2] = raw.z; t32[3] = raw.w; }
    __syncthreads();
    const int d = tid & 63, chunk = tid >> 6;
#pragma unroll
    for (int c4 = 0; c4 < 4; ++c4) { const int t0 = chunk * 32 + c4 * 8; unsigned w[4];
#pragma unroll
        for (int i = 0; i < 4; ++i) { const unsigned lo = tile[(t0 + 2 * i) * 66 + d], hi = tile[(t0 + 2 * i + 1) * 66 + d]; w[i] = lo | (hi << 16); }
        u32x4 o; o.x = w[0]; o.y = w[1]; o.z = w[2]; o.w = w[3];
        *(u32x4*)(dst + (size_t)d * dpitch + t0) = o; }
    __syncthreads();
}

__device__ __forceinline__ f32x4 mfma16(bf16x8 a, bf16x8 b, f32x4 c) { return __builtin_amdgcn_mfma_f32_16x16x32_bf16(a, b, c, 0, 0, 0); }
constexpr int KPB = 144;
template <int NK> __device__ __forceinline__ void stage_k(LAS unsigned char* Kt, const bf16_t* src, int ld, int tid) {
#pragma unroll
    for (int i = 0; i < NK / 64; ++i) { const int row = i * 64 + (tid >> 3), ch = tid & 7;
        const u32x4 v = *(const u32x4*)(src + (size_t)row * ld + ch * 8);
        *(LAS u32x4*)(Kt + row * KPB + ch * 16) = v; }
}
template <int NK> __device__ __forceinline__ void stage_vt(LAS unsigned char* Vt, const bf16_t* src, size_t gp, int tid) {
    constexpr int CPR = NK / 8, RPP = 512 / CPR, VPB = NK * 2 + 16;
#pragma unroll
    for (int i = 0; i < 64 / RPP; ++i) { const int d = i * RPP + tid / CPR, ch = tid % CPR;
        const u32x4 v = *(const u32x4*)(src + (size_t)d * gp + ch * 8);
        *(LAS u32x4*)(Vt + d * VPB + ch * 16) = v; }
}
__device__ __forceinline__ bf16x8 kfrag(const LAS unsigned char* Kt, int kt, int ks, int lr, int g) { return *(const LAS bf16x8*)(Kt + (kt * 16 + lr) * KPB + ks * 64 + g * 16); }
template <int VPB> __device__ __forceinline__ bf16x8 vfrag(const LAS unsigned char* Vt, int dt, int keybase, int lr, int g) {
    const LAS unsigned char* p = Vt + (16 * dt + lr) * VPB + (keybase + 4 * g) * 2;
    const u32x2 lo = *(const LAS u32x2*)p, hi = *(const LAS u32x2*)(p + 32);
    u32x4 w; w.x = lo.x; w.y = lo.y; w.z = hi.x; w.w = hi.y; return __builtin_bit_cast(bf16x8, w);
}
__device__ __forceinline__ bf16x8 pack_p(const f32x4 a, const f32x4 b) { u32x4 w; w.x = cvt_pk_bf16(a[0], a[1]); w.y = cvt_pk_bf16(a[2], a[3]); w.z = cvt_pk_bf16(b[0], b[1]); w.w = cvt_pk_bf16(b[2], b[3]); return __builtin_bit_cast(bf16x8, w); }
__device__ __forceinline__ void store_o16(LAS unsigned char* scr, const f32x4 (&o)[4], bf16_t* gbase, int lane) {
    const int lr = lane & 15, g = lane >> 4;
#pragma unroll
    for (int dt = 0; dt < 4; ++dt)
#pragma unroll
        for (int j = 0; j < 4; ++j) *(LAS unsigned short*)(scr + (4 * g + j) * 144 + (16 * dt + lr) * 2) = (unsigned short)(cvt_pk_bf16(o[dt][j], 0.f) & 0xffffu);
    LDS_WAIT();
#pragma unroll
    for (int c = 0; c < 2; ++c) { const int idx = lane + 64 * c, row = idx >> 3, ch = idx & 7;
        const u32x4 v = *(const LAS u32x4*)(scr + row * 144 + ch * 16);
        *(u32x4*)(gbase + (size_t)row * DM + ch * 8) = v; }
    LDS_WAIT();
}
__device__ __forceinline__ void load_qfrag(bf16x8 (&qf)[2], const bf16_t* qrow, int g) { qf[0] = *(const bf16x8*)(qrow + g * 8); qf[1] = *(const bf16x8*)(qrow + 32 + g * 8); }

__device__ __forceinline__ void sb_unit(LAS unsigned char* lds, const bf16_t* QKV, const bf16_t* SBVT, bf16_t* O, int b, int h, int qt, int tid) {
    constexpr int VPB = 128 * 2 + 16;
    LAS unsigned char* Kt = lds; LAS unsigned char* Vt = lds + 128 * KPB;
    const int lane = tid & 63, w = tid >> 6, lr = lane & 15, g = lane >> 4;
    const int t0 = qt * 128; const size_t rowbase = (size_t)b * S;
    bf16x8 qf[2]; load_qfrag(qf, QKV + (rowbase + t0 + 16 * w + lr) * QKVW + C_SBQ + h * 64, g);
    f32x4 o[4];
#pragma unroll
    for (int dt = 0; dt < 4; ++dt) o[dt] = (f32x4){0.f, 0.f, 0.f, 0.f};
    float R = 0.f; bool wdone = false;
    const int tl = 16 * w + lr;
    for (int kb = qt; kb >= 0; --kb) {
        stage_k<128>(Kt, QKV + (rowbase + (size_t)kb * 128) * QKVW + C_SBK + h * 64, QKVW, tid);
        stage_vt<128>(Vt, SBVT + ((size_t)(b * 6 + h) * 64) * S + (size_t)kb * 128, S, tid);
        __syncthreads();
        if (!wdone) {
            const int lim = (kb == qt) ? tl : 4096;
            f32x4 p[8];
#pragma unroll
            for (int kt = 0; kt < 8; ++kt) { f32x4 s = (f32x4){0.f, 0.f, 0.f, 0.f}; s = mfma16(kfrag(Kt, kt, 0, lr, g), qf[0], s); s = mfma16(kfrag(Kt, kt, 1, lr, g), qf[1], s); p[kt] = s; }
#pragma unroll
            for (int kt = 7; kt >= 0; --kt) {
                float L[4], lb[4];
#pragma unroll
                for (int j = 0; j < 4; ++j) { const float y = p[kt][j] * SC2; const float sp = fmaxf(y, 0.f) + __builtin_amdgcn_logf(1.0f + __builtin_amdgcn_exp2f(-fabsf(y)));
                    const bool valid = (kt * 16 + 4 * g + j) < lim; L[j] = valid ? -sp : 0.f; lb[j] = valid ? (y - sp) : -INFINITY; }
                const float suf2 = L[3], suf1 = L[3] + L[2], suf0 = suf1 + L[1], T = suf0 + L[0];
                const float x1 = __shfl_xor(T, 16); const float a_ = T + x1; const float x2 = __shfl_xor(a_, 32); const float tot = a_ + x2;
                const float above = (g == 0) ? (x1 + x2) : (g == 1) ? x2 : (g == 2) ? x1 : 0.f;
                const float bs = R + above;
                p[kt][0] = __builtin_amdgcn_exp2f(lb[0] + bs + suf0); p[kt][1] = __builtin_amdgcn_exp2f(lb[1] + bs + suf1);
                p[kt][2] = __builtin_amdgcn_exp2f(lb[2] + bs + suf2); p[kt][3] = __builtin_amdgcn_exp2f(lb[3] + bs);
                R += tot;
            }
#pragma unroll
            for (int i = 0; i < 4; ++i) { const bf16x8 a = pack_p(p[2 * i], p[2 * i + 1]);
#pragma unroll
                for (int dt = 0; dt < 4; ++dt) o[dt] = mfma16(a, vfrag<VPB>(Vt, dt, 32 * i, lr, g), o[dt]); }
#ifndef SB_NOEXIT
            wdone = __all(R < -150.0f);
#endif
        }
#ifdef SB_NOEXIT
        __syncthreads();
#else
        if (__syncthreads_and(wdone ? 1 : 0)) break;
#endif
    }
    store_o16(lds + 40960 + w * 2304, o, O + (rowbase + t0 + 16 * w) * DM + h * 64, lane);
    __syncthreads();
}

__device__ __forceinline__ void softmax256(f32x4 (&s)[16], float& mx, float& sum) {
    float m = -INFINITY;
#pragma unroll
    for (int kt = 0; kt < 16; ++kt) m = fmaxf(m, fmaxf(fmaxf(s[kt][0], s[kt][1]), fmaxf(s[kt][2], s[kt][3])));
    m = fmaxf(m, __shfl_xor(m, 16)); m = fmaxf(m, __shfl_xor(m, 32));
    const float ms = m * SC2; float l = 0.f;
#pragma unroll
    for (int kt = 0; kt < 16; ++kt)
#pragma unroll
        for (int j = 0; j < 4; ++j) { const float e = __builtin_amdgcn_exp2f(s[kt][j] * SC2 - ms); s[kt][j] = e; l += e; }
    l += __shfl_xor(l, 16); l += __shfl_xor(l, 32);
    mx = ms; sum = l;
}

__device__ __forceinline__ void mem_unit(LAS unsigned char* lds, const bf16_t* QKV, const bf16_t* MEMKV, const bf16_t* MEMVT, bf16_t* O, int b, int h, int qc, int tid) {
    constexpr int VPB = 256 * 2 + 16;
    LAS unsigned char* Kt = lds; LAS unsigned char* Vt = lds + 256 * KPB;
    const int lane = tid & 63, w = tid >> 6, lr = lane & 15, g = lane >> 4;
    stage_k<256>(Kt, MEMKV + (size_t)(b * MEML) * 512 + h * 64, 512, tid);
    stage_vt<256>(Vt, MEMVT + (size_t)((b * 4 + h) * 64) * MEML, MEML, tid);
    __syncthreads();
    for (int pass = 0; pass < 4; ++pass) {
        asm volatile("" ::: "memory");
        const size_t row0 = (size_t)b * S + qc * 512 + pass * 128 + 16 * w;
        bf16x8 qf[2]; load_qfrag(qf, QKV + (row0 + lr) * QKVW + C_MEQ + h * 64, g);
        f32x4 s[16];
#pragma unroll
        for (int kt = 0; kt < 16; ++kt) { f32x4 a = (f32x4){0.f, 0.f, 0.f, 0.f}; a = mfma16(kfrag(Kt, kt, 0, lr, g), qf[0], a); a = mfma16(kfrag(Kt, kt, 1, lr, g), qf[1], a); s[kt] = a; if ((kt & 3) == 3) asm volatile("" ::: "memory"); }
        float mx, sum; softmax256(s, mx, sum);
        const float inv = 1.0f / sum;
        f32x4 o[4];
#pragma unroll
        for (int dt = 0; dt < 4; ++dt) o[dt] = (f32x4){0.f, 0.f, 0.f, 0.f};
#pragma unroll
        for (int i = 0; i < 8; ++i) { const bf16x8 a = pack_p(s[2 * i] * inv, s[2 * i + 1] * inv);
#pragma unroll
            for (int dt = 0; dt < 4; ++dt) o[dt] = mfma16(a, vfrag<VPB>(Vt, dt, 32 * i, lr, g), o[dt]);
            if (i & 1) asm volatile("" ::: "memory"); }
        store_o16(lds + 73728 + w * 2304, o, O + row0 * DM + 768 + h * 64, lane);
    }
    __syncthreads();
}

__device__ __forceinline__ void moba_unit(LAS unsigned char* lds, const bf16_t* QKV, const bf16_t* MOVT, const float* KMEAN, bf16_t* O, int b, int h, int jb, int tid) {
    constexpr int VPB = 256 * 2 + 16, OP = 68;
    LAS unsigned char* Kt = lds;
    LAS unsigned char* Vt = lds + 36864;
    LAS float* Ost = (LAS float*)(lds + 70656);
    LAS float* Mst = (LAS float*)(lds + 140288);
    LAS float* Lst = Mst + 256;
    LAS unsigned char* lists = lds + 142336;
    LAS int* cnt = (LAS int*)(lds + 150528);
    LAS unsigned* sel3 = (LAS unsigned*)(lds + 150656);
    LAS float* wscr = (LAS float*)(lds + 151680);
    const int lane = tid & 63, w = tid >> 6, lr = lane & 15, g = lane >> 4;
    const size_t rowbase = (size_t)b * S; const size_t q0 = rowbase + (size_t)jb * 256;
    const bf16_t* Qb = QKV + q0 * QKVW + C_MOQ + h * 64;
    for (int i = tid; i < 256 * OP; i += 512) Ost[i] = 0.f;
    if (tid < 256) { Mst[tid] = -INFINITY; Lst[tid] = 0.f; }
    { LAS float* km = (LAS float*)Kt; const float* src = KMEAN + (size_t)((b * 6 + h) * 32) * 64; for (int i = tid; i < jb * 64; i += 512) km[i] = src[i]; }
    __syncthreads();
    {
        const int q = tid >> 1, hf = tid & 1;
        float qv[32];
        const bf16_t* qr = Qb + (size_t)q * QKVW + hf * 32;
#pragma unroll
        for (int c = 0; c < 4; ++c) { const u32x4 raw = *(const u32x4*)(qr + c * 8); qv[c * 8 + 0] = bf_lo(raw.x); qv[c * 8 + 1] = bf_hi(raw.x); qv[c * 8 + 2] = bf_lo(raw.y); qv[c * 8 + 3] = bf_hi(raw.y);
            qv[c * 8 + 4] = bf_lo(raw.z); qv[c * 8 + 5] = bf_hi(raw.z); qv[c * 8 + 6] = bf_lo(raw.w); qv[c * 8 + 7] = bf_hi(raw.w); }
        float v1 = -INFINITY, v2 = -INFINITY, v3 = -INFINITY; unsigned i1 = 255u, i2 = 255u, i3 = 255u;
        const LAS float* km = (const LAS float*)Kt + hf * 32;
        for (int n = 0; n < jb; ++n) {
            float d0 = 0.f, d1 = 0.f, d2 = 0.f, d3 = 0.f;
#pragma unroll
            for (int c = 0; c < 8; ++c) { const f32x4 kv = *(const LAS f32x4*)(km + n * 64 + c * 4); d0 += qv[c * 4] * kv[0]; d1 += qv[c * 4 + 1] * kv[1]; d2 += qv[c * 4 + 2] * kv[2]; d3 += qv[c * 4 + 3] * kv[3]; }
            float gt = (d0 + d1) + (d2 + d3);
            gt += __shfl_xor(gt, 1);
            if (gt > v1) { v3 = v2; i3 = i2; v2 = v1; i2 = i1; v1 = gt; i1 = (unsigned)n; }
            else if (gt > v2) { v3 = v2; i3 = i2; v2 = gt; i2 = (unsigned)n; }
            else if (gt > v3) { v3 = gt; i3 = (unsigned)n; }
        }
        if (hf == 0) sel3[q] = i1 | (i2 << 8) | (i3 << 16);
    }
    __syncthreads();
    for (int n = w; n < jb; n += 8) { int pos = 0;
        for (int c = 0; c < 4; ++c) { const int q = c * 64 + lane; const unsigned s = sel3[q];
            const bool f = ((s & 255u) == (unsigned)n) || (((s >> 8) & 255u) == (unsigned)n) || (((s >> 16) & 255u) == (unsigned)n);
            const unsigned long long mk = __ballot(f);
            if (f) lists[n * 256 + pos + __popcll(mk & ((1ull << lane) - 1ull))] = (unsigned char)q;
            pos += __popcll(mk); }
        if (lane == 0) cnt[n] = pos; }
    for (int n = 0; n <= jb; ++n) {
        __syncthreads();
        stage_k<256>(Kt, QKV + (rowbase + (size_t)n * 256) * QKVW + C_MOK + h * 64, QKVW, tid);
        stage_vt<256>(Vt, MOVT + ((size_t)(b * 6 + h) * 64) * S + (size_t)n * 256, S, tid);
        __syncthreads();
        const bool own = (n == jb);
        const int nq = own ? 256 : cnt[n];
        const int ntiles = (nq + 15) >> 4;
        for (int tile = w; tile < ntiles; tile += 8) {
            const int slot = 16 * tile + lr;
            int qi = own ? slot : (slot < nq ? (int)lists[n * 256 + slot] : -1);
            const int qq = qi < 0 ? 0 : qi;
            bf16x8 qf[2]; load_qfrag(qf, Qb + (size_t)qq * QKVW, g);
            f32x4 s[16];
            const int nkt = own ? (tile + 1) : 16;
#pragma unroll
            for (int kt = 0; kt < 16; ++kt) {
                if (kt < nkt) { f32x4 a = (f32x4){0.f, 0.f, 0.f, 0.f}; a = mfma16(kfrag(Kt, kt, 0, lr, g), qf[0], a); a = mfma16(kfrag(Kt, kt, 1, lr, g), qf[1], a); s[kt] = a; }
                else s[kt] = (f32x4){-INFINITY, -INFINITY, -INFINITY, -INFINITY};
                if ((kt & 3) == 3) asm volatile("" ::: "memory");
            }
            if (own) {
#pragma unroll
                for (int kt = 0; kt < 16; ++kt)
#pragma unroll
                    for (int j = 0; j < 4; ++j) if (kt * 16 + 4 * g + j > qq) s[kt][j] = -INFINITY;
            }
            float mx, sum; softmax256(s, mx, sum);
            f32x4 o[4];
#pragma unroll
            for (int dt = 0; dt < 4; ++dt) o[dt] = (f32x4){0.f, 0.f, 0.f, 0.f};
#pragma unroll
            for (int i = 0; i < 8; ++i) {
                if (2 * i < nkt) { const bf16x8 a = pack_p(s[2 * i], s[2 * i + 1]);
#pragma unroll
                    for (int dt = 0; dt < 4; ++dt) o[dt] = mfma16(a, vfrag<VPB>(Vt, dt, 32 * i, lr, g), o[dt]); }
                if (i & 1) asm volatile("" ::: "memory");
            }
            LAS float* ws_ = wscr + w * 48;
            if (g == 0) {
                float so = 1.f, sn = 0.f;
                if (qi >= 0) { const float mo = Mst[qq], lo = Lst[qq]; const float mn = fmaxf(mo, mx); so = __builtin_amdgcn_exp2f(mo - mn); sn = __builtin_amdgcn_exp2f(mx - mn); Mst[qq] = mn; Lst[qq] = lo * so + sum * sn; }
                ws_[lr] = so; ws_[16 + lr] = sn; ((LAS int*)ws_)[32 + lr] = qi;
            }
            LDS_WAIT();
#pragma unroll
            for (int j = 0; j < 4; ++j) { const int r = 4 * g + j; const float so = ws_[r], sn = ws_[16 + r]; const int qr_ = ((LAS int*)ws_)[32 + r];
                if (qr_ >= 0) {
#pragma unroll
                    for (int dt = 0; dt < 4; ++dt) { LAS float* op = Ost + qr_ * OP + 16 * dt + lr; *op = *op * so + o[dt][j] * sn; } } }
            LDS_WAIT();
        }
    }
    __syncthreads();
    { const int q = tid >> 1, hf = tid & 1; const float inv = 1.0f / Lst[q]; const LAS float* op = Ost + q * OP + hf * 32;
      bf16_t* dst = O + (q0 + q) * DM + 384 + h * 64 + hf * 32;
#pragma unroll
      for (int c = 0; c < 4; ++c) { const f32x4 a = *(const LAS f32x4*)(op + c * 8), bq = *(const LAS f32x4*)(op + c * 8 + 4);
          u32x4 wv; wv.x = cvt_pk_bf16(a[0] * inv, a[1] * inv); wv.y = cvt_pk_bf16(a[2] * inv, a[3] * inv); wv.z = cvt_pk_bf16(bq[0] * inv, bq[1] * inv); wv.w = cvt_pk_bf16(bq[2] * inv, bq[3] * inv);
          *(u32x4*)(dst + c * 8) = wv; } }
    __syncthreads();
}

#define GRID_SYNC() do { asm volatile("s_waitcnt vmcnt(0) lgkmcnt(0)" ::: "memory"); __syncthreads(); grid.sync(); __builtin_amdgcn_fence(__ATOMIC_ACQUIRE, "agent"); asm volatile("s_waitcnt vmcnt(0)" ::: "memory"); } while (0)
__global__ void __launch_bounds__(512, 2) hybrid_fwd(Params p) {
    extern __shared__ __attribute__((aligned(16))) unsigned char lds_raw[];
    LAS unsigned char* lds = (LAS unsigned char*)lds_raw;
    cg::grid_group grid = cg::this_grid();
    const int tid = threadIdx.x, lane = tid & 63, wave = __builtin_amdgcn_readfirstlane(tid >> 6);
    const int G = gridDim.x, bx = blockIdx.x;
    unsigned char* ws = p.ws;
    const float* x = p.in[0];
    bf16_t* XN = (bf16_t*)(ws + WS_XN); bf16_t* QKV = (bf16_t*)(ws + WS_QKV); bf16_t* GATES = (bf16_t*)(ws + WS_GATES);
    bf16_t* MEMN = (bf16_t*)(ws + WS_MEMN); bf16_t* MEMKV = (bf16_t*)(ws + WS_MEMKV); bf16_t* MEMVT = (bf16_t*)(ws + WS_MEMVT);
    bf16_t* SBVT = (bf16_t*)(ws + WS_SBVT); bf16_t* MOVT = (bf16_t*)(ws + WS_MOVT);
    float* SS = (float*)(ws + WS_SS); float* KMEAN = (float*)(ws + WS_KMEAN); float2* ROPE = (float2*)(ws + WS_ROPE);
    unsigned* CTL = (unsigned*)(ws + WS_CTL);
    bf16_t* Win_t = (bf16_t*)(ws + WS_WIN); bf16_t* Wfin_t = (bf16_t*)(ws + WS_WFIN); bf16_t* Wfdn_t = (bf16_t*)(ws + WS_WFDN); bf16_t* Wout_t = (bf16_t*)(ws + WS_WOUT);
    bf16_t* Wupsb_t = (bf16_t*)(ws + WS_WUPSB); bf16_t* Wupmo_t = (bf16_t*)(ws + WS_WUPMO); bf16_t* Wupme_t = (bf16_t*)(ws + WS_WUPME); bf16_t* Wmemkv_t = (bf16_t*)(ws + WS_WMEMKV);
    bf16_t* OB = XN; bf16_t* X1B = XN; bf16_t* MIX = QKV; bf16_t* HB = QKV;

#if PHMASK & 1
    {
        LAS float* scr = (LAS float*)(lds + wave * 16384);
        const int gw = bx * 8 + wave, NGW = G * 8;
        constexpr int I_IN = 16 * 176, I_FIN = 16 * 176, I_FDN = 44 * 32, I_OUT = 16 * 32, I_USB = 6 * 32, I_UMO = 6 * 32, I_UME = 4 * 32, I_MKV = 16 * 16;
        constexpr int NITEMS = I_IN + I_FIN + I_FDN + I_OUT + I_USB + I_UMO + I_UME + I_MKV;
        for (int it = gw; it < NITEMS; it += NGW) {
            int r = it;
            if (r < I_IN) { p0_transpose_item<0>(p.in[5], 1024, INW, Win_t, scr, r, lane, nullptr); continue; } r -= I_IN;
            if (r < I_FIN) { p0_transpose_item<1>(p.in[15], 1024, INW, Wfin_t, scr, r, lane, p.in[4]); continue; } r -= I_FIN;
            if (r < I_FDN) { p0_transpose_item<0>(p.in[16], DFF, 1024, Wfdn_t, scr, r, lane, nullptr); continue; } r -= I_FDN;
            if (r < I_OUT) { p0_transpose_item<0>(p.in[14], 1024, 1024, Wout_t, scr, r, lane, nullptr); continue; } r -= I_OUT;
            if (r < I_USB) { p0_transpose_item<0>(p.in[11], 384, 1024, Wupsb_t, scr, r, lane, nullptr); continue; } r -= I_USB;
            if (r < I_UMO) { p0_transpose_item<0>(p.in[12], 384, 1024, Wupmo_t, scr, r, lane, nullptr); continue; } r -= I_UMO;
            if (r < I_UME) { p0_transpose_item<0>(p.in[13], 256, 1024, Wupme_t, scr, r, lane, nullptr); continue; } r -= I_UME;
            p0_transpose_item<0>(p.in[6], 1024, 512, Wmemkv_t, scr, r, lane, nullptr);
        }
        for (int m = gw; m < M; m += NGW) rms_row_to_bf16(x + (size_t)m * DM, p.in[2], XN + (size_t)m * DM, lane);
        for (int m = gw; m < NB * MEML; m += NGW) rms_row_to_bf16(p.in[1] + (size_t)m * DM, p.in[3], MEMN + (size_t)m * DM, lane);
        for (int i = bx * 512 + tid; i < S * 32; i += G * 512) rope_entry(i, ROPE);
        for (int i = bx * 512 + tid; i < M; i += G * 512) SS[i] = 0.f;
        if (bx == 0 && tid == 0) CTL[0] = 0u;
    }
    GRID_SYNC();

#endif
#if PHMASK & 2
    {
        pg8::Gemm g{XN, Win_t, M, INW, 1024, 1024}; pg8::StaticOrder So; So.init(M, INW, G, bx);
        pg8::EpiProj E{QKV, GATES};
        pg8::gemm_phase<pg8::EpiProj, pg8::StaticOrder, true, true>(lds, g, So, E);
        pg8::Gemm g2{MEMN, Wmemkv_t, NB * MEML, 512, 1024, 1024}; pg8::StaticOrder S2; S2.init(NB * MEML, 512, G, bx);
        pg8::EpiPlain E2{MEMKV, 512};
        pg8::gemm_phase<pg8::EpiPlain, pg8::StaticOrder, true, true>(lds, g2, S2, E2);
    }
    GRID_SYNC();

#endif
#if PHMASK & 4
    {
        constexpr int N_A = 768, N_B = 768, N_C = 512, N_D = 16, N_E = 768, N_F = 768, N_G = 16;
        constexpr int NIT = N_A + N_B + N_C + N_D + N_E + N_F + N_G;
        for (int it = bx; it < NIT; it += G) {
            int r = it;
            if (r < N_A + N_B) { const bool isk = r >= N_A; if (isk) r -= N_A; const int hh = r % 6, blk = (r / 6) % 32, bb = r / 192;
                bf16_t* base = QKV + ((size_t)bb * S + blk * 256) * QKVW + (isk ? C_MOK : C_MOQ) + hh * 64;
                head_norm_item(base, QKVW, isk ? p.in[8] : p.in[7], ROPE + (size_t)blk * 256 * 32, isk ? (KMEAN + (size_t)((bb * 6 + hh) * 32 + blk) * 64) : nullptr, (LAS float*)lds, tid); continue; }
            r -= N_A + N_B;
            if (r < N_C) { const int hh = r % 4, blk = (r / 4) % 32, bb = r / 128;
                head_norm_item(QKV + ((size_t)bb * S + blk * 256) * QKVW + C_MEQ + hh * 64, QKVW, p.in[9], nullptr, nullptr, (LAS float*)lds, tid); continue; }
            r -= N_C;
            if (r < N_D) { const int hh = r % 4, bb = r / 4;
                head_norm_item(MEMKV + (size_t)(bb * MEML) * 512 + hh * 64, 512, p.in[10], nullptr, nullptr, (LAS float*)lds, tid); continue; }
            r -= N_D;
            if (r < N_E + N_F) { const bool ismo = r >= N_E; if (ismo) r -= N_E; const int hh = r % 6, blk = (r / 6) % 32, bb = r / 192;
                transpose_item256(QKV + ((size_t)bb * S + blk * 256) * QKVW + (ismo ? C_MOV : C_SBV) + hh * 64, QKVW, (ismo ? MOVT : SBVT) + ((size_t)(bb * 6 + hh) * 64) * S + (size_t)blk * 256, S, (LAS unsigned short*)lds, tid); continue; }
            r -= N_E + N_F;
            { const int hh = r % 4, bb = r / 4;
              transpose_item256(MEMKV + (size_t)(bb * MEML) * 512 + 256 + hh * 64, 512, MEMVT + (size_t)((bb * 4 + hh) * 64) * MEML, MEML, (LAS unsigned short*)lds, tid); }
        }
    }
    GRID_SYNC();

#endif
#if PHMASK & 8
    {
        LAS unsigned* shu = (LAS unsigned*)(lds + LDS_BYTES - 16);
        constexpr int U_MO = 768, U_SB = 1536, U_ME = 256;
        for (;;) {
            __syncthreads();
            if (tid == 0) shu[0] = atomicAdd(CTL, 1u);
            __syncthreads();
            const int u = (int)shu[0];
            if (u >= U_MO + U_SB + U_ME) break;
#ifndef UMASK
#define UMASK 7
#endif
            if (u < U_MO) {
#if UMASK & 1
                const int jb = 31 - u / 24, bh = u % 24; int t2 = tid; asm volatile("" : "+v"(t2)); moba_unit(lds, QKV, MOVT, KMEAN, OB, bh / 6, bh % 6, jb, t2);
#endif
            } else if (u < U_MO + U_SB) {
#if UMASK & 2
                const int v = u - U_MO; const int qt = 63 - v / 24, bh = v % 24; int t2 = tid; asm volatile("" : "+v"(t2)); sb_unit(lds, QKV, SBVT, OB, bh / 6, bh % 6, qt, t2);
#endif
            } else {
#if UMASK & 4
                const int v = u - U_MO - U_SB; const int qc = v / 16, bh = v % 16; int t2 = tid; asm volatile("" : "+v"(t2)); mem_unit(lds, QKV, MEMKV, MEMVT, OB, bh / 4, bh % 4, qc, t2);
#endif
            }
        }
    }
    GRID_SYNC();

#endif
#if PHMASK & 16
    {
        pg8::StaticOrder So; So.init(M, 1024, G, bx);
#ifndef P3MASK
#define P3MASK 7
#endif
        if (P3MASK & 1) { pg8::Gemm g{OB, Wupsb_t, M, 1024, 384, 1024}; pg8::EpiGate<true> E{MIX, GATES, 0}; pg8::gemm_phase<pg8::EpiGate<true>, pg8::StaticOrder, true, true>(lds, g, So, E); }
        if (P3MASK & 2) { pg8::Gemm g{OB + 384, Wupmo_t, M, 1024, 384, 1024}; pg8::EpiGate<false> E{MIX, GATES, 1024}; pg8::gemm_phase<pg8::EpiGate<false>, pg8::StaticOrder, true, true>(lds, g, So, E); }
        if (P3MASK & 4) { pg8::Gemm g{OB + 768, Wupme_t, M, 1024, 256, 1024}; pg8::EpiGate<false> E{MIX, GATES, 2048}; pg8::gemm_phase<pg8::EpiGate<false>, pg8::StaticOrder, true, true>(lds, g, So, E); }
    }
    GRID_SYNC();

#endif
#if PHMASK & 32
    {
        pg8::Gemm g{MIX, Wout_t, M, 1024, 1024, 1024}; pg8::StaticOrder So; So.init(M, 1024, G, bx);
        pg8::EpiRes1 E{x, p.out, X1B, SS};
        pg8::gemm_phase<pg8::EpiRes1, pg8::StaticOrder, true, true>(lds, g, So, E);
    }
    GRID_SYNC();

#endif
#if PHMASK & 64
    {
        pg8::Gemm g{X1B, Wfin_t, M, INW, 1024, 1024}; pg8::StaticOrder So; So.init(M, INW, G, bx);
        pg8::EpiSwiGLU E{HB, SS};
        pg8::gemm_phase<pg8::EpiSwiGLU, pg8::StaticOrder, true, true>(lds, g, So, E);
    }
    GRID_SYNC();

#endif
#if PHMASK & 128
    {
        pg8::Gemm g{HB, Wfdn_t, M, 1024, DFF, DFF}; pg8::StaticOrder So; So.init(M, 1024, G, bx);
        pg8::EpiRes2 E{p.out};
        pg8::gemm_phase<pg8::EpiRes2, pg8::StaticOrder, true, true>(lds, g, So, E);
    }
#endif
#ifdef DUMP_OFF
    GRID_SYNC();
    { const bf16_t* src = (const bf16_t*)(ws + (size_t)DUMP_OFF * MiB); const size_t N1 = (size_t)M * DM;
      for (size_t i = (size_t)bx * 512 + tid; i < N1; i += (size_t)G * 512) { float a = 0.f;
          for (int k = 0; k < DUMP_NK; ++k) { const unsigned v = src[i + (size_t)k * N1]; a += __uint_as_float(v << 16); }
          p.out[i] = a; } }
#endif
}

extern "C" void kernel_launch(void* const* d_in, const int* in_sizes, int n_in, void* d_out, int out_size, void* d_ws, size_t ws_size, hipStream_t stream) {
    static int grid = 0;
    if (grid == 0) {
        if (n_in != 17 || out_size != M * DM || ws_size < WS_END) { fprintf(stderr, "kernel_launch: unexpected shapes: n_in %d out %d ws %zu (need %zu)\n", n_in, out_size, ws_size, (size_t)WS_END); grid = -1; return; }
        int dev = 0, cus = 0, per_cu = 0;
        hipGetDevice(&dev); hipDeviceGetAttribute(&cus, hipDeviceAttributeMultiprocessorCount, dev);
        if (hipFuncSetAttribute((const void*)hybrid_fwd, hipFuncAttributeMaxDynamicSharedMemorySize, LDS_BYTES) != hipSuccess) { fprintf(stderr, "kernel_launch: hipFuncSetAttribute(%d B LDS) failed\n", LDS_BYTES); }
        if (hipOccupancyMaxActiveBlocksPerMultiprocessor(&per_cu, (const void*)hybrid_fwd, 512, LDS_BYTES) != hipSuccess || per_cu < 1) fprintf(stderr, "kernel_launch: occupancy query says %d blocks/CU\n", per_cu);
        (void)hipGetLastError();
        grid = cus > 0 ? cus : 256;
    }
    if (grid < 0) return;
    Params p{};
    for (int i = 0; i < 17; ++i) p.in[i] = (const float*)d_in[i];
    p.out = (float*)d_out; p.ws = (unsigned char*)d_ws;
    void* args[] = {&p};
    hipError_t e = hipLaunchCooperativeKernel((const void*)hybrid_fwd, dim3(grid), dim3(512), args, LDS_BYTES, stream);
    if (e != hipSuccess) fprintf(stderr, "kernel_launch: cooperative launch failed: %s (grid %d)\n", hipGetErrorString(e), grid);
}
```

```cpp
#include <hip/hip_runtime.h>
#include <hip/hip_cooperative_groups.h>
#include <cstdio>
#include <cstdint>
namespace cg = cooperative_groups;
namespace pg8 {
#define PG8_LAS __attribute__((address_space(3)))
typedef unsigned short bf16_t;
typedef short bf16x8 __attribute__((ext_vector_type(8)));
typedef float f32x4 __attribute__((ext_vector_type(4)));
typedef unsigned u32x4 __attribute__((ext_vector_type(4)));
constexpr int BM = 256, BK = 64, HALF = 128, HTB = HALF * BK * 2  , STAGE_BYTES = 8 * HTB, NXCD = 8;

__host__ __device__ __forceinline__ int lds_byte(int r, int c) { const int st = (r >> 4) * 2 + (c >> 5), rr = r & 15, cc = c & 31, ob = rr * 64 + cc * 2; return st * 1024 + (ob ^ (((ob >> 9) & 1) << 5)); }
__host__ __device__ __forceinline__ void stage_rc(int b, int& R, int& C) { const int st = b / 1024, sb = b % 1024, swz = sb ^ (((sb >> 9) & 1) << 5); R = (st >> 1) * 16 + swz / 64; C = (st & 1) * 32 + (swz % 64) / 2; }
__host__ __device__ __forceinline__ int perm32(int rho) { const int n = rho >> 4, i = rho & 15; return 8 * (i >> 2) + 4 * n + (i & 3); }

struct Unit { int pm, pn; };
struct Gemm { const bf16_t* A; const bf16_t* Bt; int M, N, K, lda; };

struct StaticOrder {
    int nM, nN, nwg, G, c, WGM;
    __host__ __device__ void init(int M, int N, int G_, int c_, int wgm_ = 4) { nM = M / BM; nN = N / BM; nwg = nM * nN; G = G_; c = c_; WGM = wgm_; }
    __host__ __device__ bool next(int i, Unit& u) const {
        const long L = (long)i * G + c; if (L >= nwg) return false;
        int wgid = (int)L; { const int q = nwg / NXCD, r = nwg % NXCD, xcd = wgid % NXCD, off = wgid / NXCD; wgid = (xcd < r ? xcd * (q + 1) : r * (q + 1) + (xcd - r) * q) + off; }
        const int nig = WGM * nN, gid = wgid / nig, fm = gid * WGM, gsz = (nM - fm) < WGM ? (nM - fm) : WGM;
        u.pm = fm + ((wgid % nig) % gsz); u.pn = (wgid % nig) / gsz; return true;
    }
    __device__ __forceinline__ void a_ready(const Unit&) const {}
    __device__ __forceinline__ void done(const Unit&) const {}
};

typedef __bf16 bf16v2_t __attribute__((ext_vector_type(2)));
typedef float f32v2_t __attribute__((ext_vector_type(2)));
__device__ __forceinline__ unsigned cvt_pk_bf16(float lo, float hi) { const f32v2_t v = {lo, hi}; const bf16v2_t b = __builtin_convertvector(v, bf16v2_t); return __builtin_bit_cast(unsigned, b); }
typedef float f32x2 __attribute__((ext_vector_type(2)));

typedef unsigned u32x2 __attribute__((ext_vector_type(2)));
__device__ __forceinline__ float bf_lo(unsigned u) { return __uint_as_float(u << 16); }
__device__ __forceinline__ float bf_hi(unsigned u) { return __uint_as_float(u & 0xffff0000u); }
__device__ __forceinline__ float sigmoidf_(float v) { return __builtin_amdgcn_rcpf(1.0f + __builtin_amdgcn_exp2f(-1.4426950408889634f * v)); }

struct EpiProj {
    static constexpr bool PERM = true, AFTER_DRAIN = false;
    bf16_t* QKV; bf16_t* GATES;
    __device__ __forceinline__ void operator()(const f32x4 (&acc)[2][2][4][2], const Unit& u, int wr, int wc, int fr, int fq) const {
        const int row0 = u.pm * BM + wr * 64 + fr;
        const bool isg = u.pn >= 10;
        bf16_t* base = isg ? GATES : QKV; const int ldc = isg ? 3072 : 2560; const int colt = isg ? (u.pn - 10) * BM : u.pn * BM;
        const int col0 = colt + wc * 32 + 8 * fq;
#pragma unroll
        for (int ai = 0; ai < 2; ++ai)
#pragma unroll
            for (int m = 0; m < 4; ++m) { bf16_t* rowp = base + (size_t)(row0 + ai * HALF + m * 16) * ldc + col0;
#pragma unroll
                for (int bj = 0; bj < 2; ++bj) { f32x4 v0 = acc[ai][bj][m][0], v1 = acc[ai][bj][m][1];
                    u32x4 w; w.x = cvt_pk_bf16(v0[0], v0[1]); w.y = cvt_pk_bf16(v0[2], v0[3]); w.z = cvt_pk_bf16(v1[0], v1[1]); w.w = cvt_pk_bf16(v1[2], v1[3]);
                    __builtin_nontemporal_store(w, (u32x4*)(rowp + bj * HALF)); } }
    }
};
struct EpiPlain {
    static constexpr bool PERM = true, AFTER_DRAIN = false;
    bf16_t* O; int ldc;
    __device__ __forceinline__ void operator()(const f32x4 (&acc)[2][2][4][2], const Unit& u, int wr, int wc, int fr, int fq) const {
        const int row0 = u.pm * BM + wr * 64 + fr; const int col0 = u.pn * BM + wc * 32 + 8 * fq;
#pragma unroll
        for (int ai = 0; ai < 2; ++ai)
#pragma unroll
            for (int m = 0; m < 4; ++m) { bf16_t* rowp = O + (size_t)(row0 + ai * HALF + m * 16) * ldc + col0;
#pragma unroll
                for (int bj = 0; bj < 2; ++bj) { const f32x4 v0 = acc[ai][bj][m][0], v1 = acc[ai][bj][m][1];
                    u32x4 w; w.x = cvt_pk_bf16(v0[0], v0[1]); w.y = cvt_pk_bf16(v0[2], v0[3]); w.z = cvt_pk_bf16(v1[0], v1[1]); w.w = cvt_pk_bf16(v1[2], v1[3]);
                    *(u32x4*)(rowp + bj * HALF) = w; } }
    }
};
template <bool FIRST> struct EpiGate {
    static constexpr bool PERM = true, AFTER_DRAIN = false;
    bf16_t* MIX; const bf16_t* GATES; int goff;
    __device__ __forceinline__ void operator()(const f32x4 (&acc)[2][2][4][2], const Unit& u, int wr, int wc, int fr, int fq) const {
        const unsigned row0 = u.pm * BM + wr * 64 + fr; const unsigned col0 = u.pn * BM + wc * 32 + 8 * fq;
        const char* gb = (const char*)(GATES + goff); char* mb = (char*)MIX;
#pragma unroll
        for (int ai = 0; ai < 2; ++ai)
#pragma unroll
            for (int m = 0; m < 4; ++m) { const unsigned row = row0 + ai * HALF + m * 16;
#pragma unroll
                for (int bj = 0; bj < 2; ++bj) { const f32x4 v0 = acc[ai][bj][m][0], v1 = acc[ai][bj][m][1];
                    const unsigned goffb = (row * 3072u + col0 + bj * HALF) * 2u, moffb = (row * 1024u + col0 + bj * HALF) * 2u;
                    const u32x4 gt = *(const u32x4*)(gb + goffb);
                    float r[8];
                    r[0] = v0[0] * sigmoidf_(bf_lo(gt.x)); r[1] = v0[1] * sigmoidf_(bf_hi(gt.x)); r[2] = v0[2] * sigmoidf_(bf_lo(gt.y)); r[3] = v0[3] * sigmoidf_(bf_hi(gt.y));
                    r[4] = v1[0] * sigmoidf_(bf_lo(gt.z)); r[5] = v1[1] * sigmoidf_(bf_hi(gt.z)); r[6] = v1[2] * sigmoidf_(bf_lo(gt.w)); r[7] = v1[3] * sigmoidf_(bf_hi(gt.w));
                    if (!FIRST) { const u32x4 pv = *(const u32x4*)(mb + moffb);
                        r[0] += bf_lo(pv.x); r[1] += bf_hi(pv.x); r[2] += bf_lo(pv.y); r[3] += bf_hi(pv.y); r[4] += bf_lo(pv.z); r[5] += bf_hi(pv.z); r[6] += bf_lo(pv.w); r[7] += bf_hi(pv.w); }
                    u32x4 w; w.x = cvt_pk_bf16(r[0], r[1]); w.y = cvt_pk_bf16(r[2], r[3]); w.z = cvt_pk_bf16(r[4], r[5]); w.w = cvt_pk_bf16(r[6], r[7]);
                    *(u32x4*)(mb + moffb) = w; }
                if (m == 3) asm volatile("" ::: "memory"); }
    }
};
struct EpiRes1 {
    static constexpr bool PERM = true, AFTER_DRAIN = false;
    const float* X; float* OUT; bf16_t* X1B; float* SS;
    __device__ __forceinline__ void operator()(const f32x4 (&acc)[2][2][4][2], const Unit& u, int wr, int wc, int fr, int fq) const {
        const int row0 = u.pm * BM + wr * 64 + fr; const int col0 = u.pn * BM + wc * 32 + 8 * fq;
#pragma unroll
        for (int ai = 0; ai < 2; ++ai) {
            f32x4 xr[4][2][2];
#pragma unroll
            for (int m = 0; m < 4; ++m)
#pragma unroll
                for (int bj = 0; bj < 2; ++bj) { const size_t off = (size_t)(row0 + ai * HALF + m * 16) * 1024 + col0 + bj * HALF;
                    xr[m][bj][0] = *(const f32x4*)(X + off); xr[m][bj][1] = *(const f32x4*)(X + off + 4); }
#pragma unroll
            for (int m = 0; m < 4; ++m) { const size_t row = (size_t)(row0 + ai * HALF + m * 16); float ss = 0.f;
#pragma unroll
                for (int bj = 0; bj < 2; ++bj) { const size_t off = row * 1024 + col0 + bj * HALF;
                    const f32x4 v0 = acc[ai][bj][m][0] + xr[m][bj][0], v1 = acc[ai][bj][m][1] + xr[m][bj][1];
                    __builtin_nontemporal_store(v0, (f32x4*)(OUT + off)); __builtin_nontemporal_store(v1, (f32x4*)(OUT + off + 4));
                    ss += (v0[0] * v0[0] + v0[1] * v0[1]) + (v0[2] * v0[2] + v0[3] * v0[3]) + (v1[0] * v1[0] + v1[1] * v1[1]) + (v1[2] * v1[2] + v1[3] * v1[3]);
                    u32x4 w; w.x = cvt_pk_bf16(v0[0], v0[1]); w.y = cvt_pk_bf16(v0[2], v0[3]); w.z = cvt_pk_bf16(v1[0], v1[1]); w.w = cvt_pk_bf16(v1[2], v1[3]);
                    __builtin_nontemporal_store(w, (u32x4*)(X1B + off)); }
                ss += __shfl_xor(ss, 16); ss += __shfl_xor(ss, 32);
                if (fq == 0) __hip_atomic_fetch_add(SS + row, ss, __ATOMIC_RELAXED, __HIP_MEMORY_SCOPE_AGENT); }
            asm volatile("" ::: "memory"); }
    }
};
struct EpiSwiGLU {
    static constexpr bool PERM = true, AFTER_DRAIN = false;
    bf16_t* HB; const float* SS;
    __device__ __forceinline__ void operator()(const f32x4 (&acc)[2][2][4][2], const Unit& u, int wr, int wc, int fr, int fq) const {
        const int row0 = u.pm * BM + wr * 64 + fr; const int col0 = u.pn * HALF + wc * 32 + 8 * fq;
#pragma unroll
        for (int ai = 0; ai < 2; ++ai)
#pragma unroll
            for (int m = 0; m < 4; ++m) { const size_t row = (size_t)(row0 + ai * HALF + m * 16);
                const float rstd = __builtin_amdgcn_rsqf(SS[row] * (1.0f / 1024.0f) + 1e-6f);
                float r[8];
#pragma unroll
                for (int n = 0; n < 2; ++n)
#pragma unroll
                    for (int e = 0; e < 4; ++e) { const float gt = acc[ai][0][m][n][e] * rstd, up = acc[ai][1][m][n][e] * rstd; r[4 * n + e] = gt * sigmoidf_(gt) * up; }
                u32x4 w; w.x = cvt_pk_bf16(r[0], r[1]); w.y = cvt_pk_bf16(r[2], r[3]); w.z = cvt_pk_bf16(r[4], r[5]); w.w = cvt_pk_bf16(r[6], r[7]);
                __builtin_nontemporal_store(w, (u32x4*)(HB + row * 2816 + col0)); }
    }
};
struct EpiRes2 {
    static constexpr bool PERM = true, AFTER_DRAIN = false;
    float* OUT; const float* SRC;
    __device__ __forceinline__ void operator()(const f32x4 (&acc)[2][2][4][2], const Unit& u, int wr, int wc, int fr, int fq) const {
        const int row0 = u.pm * BM + wr * 64 + fr; const int col0 = u.pn * BM + wc * 32 + 8 * fq;
#pragma unroll
        for (int ai = 0; ai < 2; ++ai) {
            f32x4 xr[4][2][2];
#pragma unroll
            for (int m = 0; m < 4; ++m)
#pragma unroll
                for (int bj = 0; bj < 2; ++bj) { const size_t off = (size_t)(row0 + ai * HALF + m * 16) * 1024 + col0 + bj * HALF;
                    xr[m][bj][0] = *(const f32x4*)(SRC + off); xr[m][bj][1] = *(const f32x4*)(SRC + off + 4); }
#pragma unroll
            for (int m = 0; m < 4; ++m)
#pragma unroll
                for (int bj = 0; bj < 2; ++bj) { const size_t off = (size_t)(row0 + ai * HALF + m * 16) * 1024 + col0 + bj * HALF;
                    __builtin_nontemporal_store(acc[ai][bj][m][0] + xr[m][bj][0], (f32x4*)(OUT + off)); __builtin_nontemporal_store(acc[ai][bj][m][1] + xr[m][bj][1], (f32x4*)(OUT + off + 4)); }
            asm volatile("" ::: "memory"); }
    }
};
template <class Epi, class Sched, bool ALIGN_EPI = false, bool SP2 = false>
__device__ __forceinline__ void gemm_phase(PG8_LAS unsigned char* lds, const Gemm g, const Sched& S, const Epi& E) {
    const int tid = threadIdx.x, wid = __builtin_amdgcn_readfirstlane(tid >> 6), lane = tid & 63, wr = wid >> 2, wc = wid & 3, fr = lane & 15, fq = lane >> 4;
    const int K = g.K, nt = K / BK;
    unsigned voffA[2], voffB[2];
#pragma unroll
    for (int i = 0; i < 2; ++i) { int R, C; stage_rc(tid * 16 + i * 8192, R, C); const int Rb = Epi::PERM ? ((R & ~31) + perm32(R & 31)) : R;
        voffA[i] = (unsigned)(R * g.lda + C) * 2u; voffB[i] = (unsigned)(Rb * K + C) * 2u; }
    const size_t kstep = (size_t)(BK * 2);
    const size_t hstep = (size_t)HALF * K * 2, hstepA = (size_t)HALF * g.lda * 2;
    const size_t tstep = 2 * hstep, tstepA = 2 * hstepA;
    const unsigned ldsw = (unsigned)wid * 1024u;
    const int aoff = lds_byte(wr * 64 + fr, fq * 8), boff = lds_byte(wc * 32 + fr, fq * 8);
#define PG8_SA(b, h) (((b) * 2 + (h)) * HTB)
#define PG8_SB(b, h) ((4 + (b) * 2 + (h)) * HTB)
#define PG8_STAGE(bufoff, gbase, voff) do { _Pragma("unroll") for (int _i = 0; _i < 2; ++_i) \
        __builtin_amdgcn_global_load_lds((const unsigned*)((const char*)(gbase) + (voff)[_i]), (PG8_LAS unsigned*)(lds + (bufoff) + ldsw + _i * 8192), 16, 0, 0); } while (0)
#define PG8_LDA(dst, b, h) do { _Pragma("unroll") for (int m = 0; m < 4; ++m) _Pragma("unroll") for (int k = 0; k < 2; ++k) dst[m][k] = *(const PG8_LAS bf16x8*)(lds + PG8_SA(b, h) + aoff + m * 2048 + k * 1024); } while (0)
#define PG8_LDB(dst, b, h) do { _Pragma("unroll") for (int n = 0; n < 2; ++n) _Pragma("unroll") for (int k = 0; k < 2; ++k) dst[n][k] = *(const PG8_LAS bf16x8*)(lds + PG8_SB(b, h) + boff + n * 2048 + k * 1024); } while (0)
#define PG8_MMA(ai, bj, At, Bt) do { __builtin_amdgcn_s_setprio(1); _Pragma("unroll") for (int m = 0; m < 4; ++m) _Pragma("unroll") for (int n = 0; n < 2; ++n) _Pragma("unroll") for (int k = 0; k < 2; ++k) \
        acc[ai][bj][m][n] = __builtin_amdgcn_mfma_f32_16x16x32_bf16(Bt[n][k], At[m][k], acc[ai][bj][m][n], 0, 0, 0); __builtin_amdgcn_s_setprio(0); } while (0)
#define PG8_WAIT_V(n) asm volatile("s_waitcnt vmcnt(" #n ")" ::: "memory")
#define PG8_WAIT_L(n) asm volatile("s_waitcnt lgkmcnt(" #n ")" ::: "memory")
#define PG8_BAR __builtin_amdgcn_s_barrier()
#define PG8_SCHED __builtin_amdgcn_sched_barrier(0)
    Unit cur, nxt; int ui = 0;
    if (!S.next(0, cur)) return;
    f32x4 acc[2][2][4][2];
#pragma unroll
    for (int a = 0; a < 2; ++a)
#pragma unroll
        for (int b = 0; b < 2; ++b)
#pragma unroll
            for (int m = 0; m < 4; ++m)
#pragma unroll
                for (int n = 0; n < 2; ++n) acc[a][b][m][n] = (f32x4){0.f, 0.f, 0.f, 0.f};
    bf16x8 At[4][2], B0[2][2], B1[2][2];
    const char* cA = (const char*)g.A + (size_t)cur.pm * tstepA; const char* cB = (const char*)g.Bt + (size_t)cur.pn * tstep;
    S.a_ready(cur);
    if constexpr (SP2) {
        PG8_STAGE(PG8_SB(0, 0), cB, voffB); PG8_STAGE(PG8_SB(0, 1), cB + hstep, voffB); PG8_STAGE(PG8_SA(0, 0), cA, voffA); PG8_STAGE(PG8_SA(0, 1), cA + hstepA, voffA);
        if (wr == 1) PG8_BAR;
        PG8_WAIT_V(2); PG8_BAR;
        PG8_STAGE(PG8_SB(1, 0), cB + kstep, voffB); PG8_STAGE(PG8_SA(1, 0), cA + kstep, voffA); PG8_STAGE(PG8_SB(1, 1), cB + hstep + kstep, voffB);
        PG8_WAIT_V(6); PG8_BAR;
    } else {
        PG8_STAGE(PG8_SB(0, 0), cB, voffB); PG8_STAGE(PG8_SA(0, 0), cA, voffA); PG8_STAGE(PG8_SB(0, 1), cB + hstep, voffB); PG8_STAGE(PG8_SA(0, 1), cA + hstepA, voffA);
        if (wr == 1) PG8_BAR;
        PG8_WAIT_V(4); PG8_BAR;
        PG8_STAGE(PG8_SB(1, 0), cB + kstep, voffB); PG8_STAGE(PG8_SA(1, 0), cA + kstep, voffA); PG8_STAGE(PG8_SB(1, 1), cB + hstep + kstep, voffB);
        PG8_WAIT_V(6); PG8_BAR;
    }
    for (;;) {
        const bool has_next = S.next(ui + 1, nxt);
        const char* nA = has_next ? (const char*)g.A + (size_t)nxt.pm * tstepA : cA; const char* nB = has_next ? (const char*)g.Bt + (size_t)nxt.pn * tstep : cB;
#pragma nounroll
        for (int t = 0; t < nt; t += 2) {
            const bool last = (t == nt - 2);
            const char* a1 = cA + (size_t)(t + 1) * kstep;
            const char* a2 = last ? nA : cA + (size_t)(t + 2) * kstep; const char* b2 = last ? nB : cB + (size_t)(t + 2) * kstep;
            const char* a3 = a2 + kstep; const char* b3 = b2 + kstep;
            if (last && has_next) S.a_ready(nxt);
            if constexpr (SP2) {
            PG8_LDB(B0, 0, 0); PG8_LDB(B1, 0, 1); PG8_SCHED; PG8_LDA(At, 0, 0); PG8_STAGE(PG8_SA(1, 1), a1 + hstepA, voffA);
            PG8_WAIT_V(8); PG8_WAIT_L(0); PG8_BAR; PG8_MMA(0, 0, At, B0); PG8_MMA(0, 1, At, B1); PG8_BAR; PG8_SCHED;
            PG8_LDA(At, 0, 1); PG8_STAGE(PG8_SB(0, 0), b2, voffB); PG8_STAGE(PG8_SB(0, 1), b2 + hstep, voffB); PG8_STAGE(PG8_SA(0, 0), a2, voffA);
            PG8_WAIT_V(8); PG8_WAIT_L(0); PG8_BAR; PG8_MMA(1, 0, At, B0); PG8_MMA(1, 1, At, B1); PG8_BAR; PG8_SCHED;
            PG8_LDB(B0, 1, 0); PG8_LDB(B1, 1, 1); PG8_SCHED; PG8_LDA(At, 1, 0); PG8_STAGE(PG8_SA(0, 1), a2 + hstepA, voffA);
            PG8_WAIT_V(8); PG8_WAIT_L(0); PG8_BAR; PG8_MMA(0, 0, At, B0); PG8_MMA(0, 1, At, B1); PG8_BAR; PG8_SCHED;
            PG8_LDA(At, 1, 1); PG8_STAGE(PG8_SB(1, 0), b3, voffB); PG8_STAGE(PG8_SB(1, 1), b3 + hstep, voffB); PG8_STAGE(PG8_SA(1, 0), a3, voffA);
            PG8_WAIT_V(8); PG8_WAIT_L(0); PG8_BAR; PG8_MMA(1, 0, At, B0); PG8_MMA(1, 1, At, B1); PG8_BAR; PG8_SCHED;
            } else {
            PG8_LDB(B0, 0, 0); PG8_SCHED; PG8_LDA(At, 0, 0); PG8_STAGE(PG8_SA(1, 1), a1 + hstepA, voffA);
            PG8_WAIT_L(8); PG8_BAR; PG8_WAIT_L(0); PG8_MMA(0, 0, At, B0); PG8_BAR; PG8_SCHED;
            PG8_LDB(B1, 0, 1); PG8_STAGE(PG8_SB(0, 0), b2, voffB);
            PG8_BAR; PG8_WAIT_L(0); PG8_MMA(0, 1, At, B1); PG8_BAR;
            PG8_LDA(At, 0, 1); PG8_STAGE(PG8_SA(0, 0), a2, voffA);
            PG8_BAR; PG8_WAIT_L(0); PG8_MMA(1, 0, At, B0); PG8_BAR; PG8_SCHED;
            PG8_STAGE(PG8_SB(0, 1), b2 + hstep, voffB);
            PG8_WAIT_V(6); PG8_BAR; PG8_MMA(1, 1, At, B1); PG8_BAR;
            PG8_LDB(B0, 1, 0); PG8_SCHED; PG8_LDA(At, 1, 0); PG8_STAGE(PG8_SA(0, 1), a2 + hstepA, voffA);
            PG8_WAIT_L(8); PG8_BAR; PG8_WAIT_L(0); PG8_MMA(0, 0, At, B0); PG8_BAR; PG8_SCHED;
            PG8_LDB(B1, 1, 1); PG8_STAGE(PG8_SB(1, 0), b3, voffB);
            PG8_BAR; PG8_WAIT_L(0); PG8_MMA(0, 1, At, B1); PG8_BAR;
            PG8_LDA(At, 1, 1); PG8_STAGE(PG8_SA(1, 0), a3, voffA);
            PG8_BAR; PG8_WAIT_L(0); PG8_MMA(1, 0, At, B0); PG8_BAR; PG8_SCHED;
            PG8_STAGE(PG8_SB(1, 1), b3 + hstep, voffB);
            PG8_WAIT_V(6); PG8_BAR; PG8_MMA(1, 1, At, B1); PG8_BAR;
            }
        }
        if constexpr (ALIGN_EPI) { if (wr == 0) PG8_BAR; }
        if constexpr (!Epi::AFTER_DRAIN) { E(acc, cur, wr, wc, fr, fq); S.done(cur); }
        if (!has_next) break;
#pragma unroll
        for (int a = 0; a < 2; ++a)
#pragma unroll
            for (int b = 0; b < 2; ++b)
#pragma unroll
                for (int m = 0; m < 4; ++m)
#pragma unroll
                    for (int n = 0; n < 2; ++n) acc[a][b][m][n] = (f32x4){0.f, 0.f, 0.f, 0.f};
        cur = nxt; cA = nA; cB = nB; ++ui;
        if constexpr (ALIGN_EPI) { if (wr == 1) PG8_BAR; }
    }
    PG8_WAIT_V(0);
    if constexpr (!ALIGN_EPI) { if (wr == 0) PG8_BAR; }
    PG8_BAR;
    if constexpr (Epi::AFTER_DRAIN) { E.fused(acc, cur, wr, wc, fr, fq, lds, wid, lane); S.done(cur); }
#undef PG8_SA
#undef PG8_SB
#undef PG8_STAGE
#undef PG8_LDA
#undef PG8_LDB
#undef PG8_MMA
#undef PG8_WAIT_V
#undef PG8_WAIT_L
#undef PG8_BAR
#undef PG8_SCHED
}
}

#define LAS __attribute__((address_space(3)))
typedef unsigned short bf16_t;
typedef short bf16x8 __attribute__((ext_vector_type(8)));
typedef float f32x4 __attribute__((ext_vector_type(4)));
typedef unsigned u32x4 __attribute__((ext_vector_type(4)));
typedef unsigned u32x2 __attribute__((ext_vector_type(2)));
using pg8::cvt_pk_bf16; using pg8::bf_lo; using pg8::bf_hi;

constexpr int NB = 4, S = 8192, DM = 1024, M = NB * S, INW = 5632, DFF = 2816, MEML = 256;
constexpr int QKVW = 2560, GW = 3072;
constexpr int C_SBQ = 0, C_SBK = 384, C_SBV = 768, C_MOQ = 1152, C_MOK = 1536, C_MOV = 1920, C_MEQ = 2304;
constexpr float EPS = 1e-6f;
constexpr float LOG2E = 1.4426950408889634f;
constexpr float SC2 = LOG2E * 0.125f;

constexpr size_t MiB = (size_t)1 << 20;
constexpr size_t WS_CTL = 0;
constexpr size_t WS_BAR = 16 * 1024;
constexpr size_t WS_SS = 64 * 1024;
constexpr size_t WS_KMEAN = 256 * 1024;
constexpr size_t WS_MEMN = 1 * MiB;
constexpr size_t WS_MEMKV = 3 * MiB;
constexpr size_t WS_MEMVT = 4 * MiB;
constexpr size_t WS_WMEMKV = 5 * MiB;
constexpr size_t WS_WIN = 6 * MiB;
constexpr size_t WS_WFIN = 17 * MiB;
constexpr size_t WS_WFDN = 28 * MiB;
constexpr size_t WS_WOUT = 34 * MiB;
constexpr size_t WS_WUPSB = 36 * MiB, WS_WUPMO = 37 * MiB, WS_WUPME = 38 * MiB;
constexpr size_t WS_SEL = 39 * MiB;
constexpr size_t WS_XN = 40 * MiB;
constexpr size_t WS_SBVT = 104 * MiB, WS_MOVT = 128 * MiB;
constexpr size_t WS_QKV = 152 * MiB;
constexpr size_t WS_GATES = 312 * MiB;
constexpr size_t WS_ROPE = 504 * MiB;
constexpr size_t WS_END = 506 * MiB;
constexpr int LDS_BYTES = 156 * 1024;

#ifndef PHMASK
#define PHMASK 255
#endif
#ifndef WGM_WIDE
#define WGM_WIDE 4
#endif
#ifndef WGM_P3
#define WGM_P3 8
#endif
#ifndef WGM_P4
#define WGM_P4 8
#endif
#ifndef WGM_P6
#define WGM_P6 8
#endif
struct Params { const float* in[17]; float* out; unsigned char* ws; };

__device__ __forceinline__ float wave_sum(float v) {
#pragma unroll
    for (int o = 1; o < 64; o <<= 1) v += __shfl_xor(v, o);
    return v;
}
#define LDS_WAIT() asm volatile("s_waitcnt lgkmcnt(0)" ::: "memory")
#define BAR_LDS() do { asm volatile("s_waitcnt lgkmcnt(0)" ::: "memory"); __builtin_amdgcn_s_barrier(); asm volatile("" ::: "memory"); } while (0)

template <int MODE>
__device__ __forceinline__ void p0_transpose_item(const float* W, int K, int N, bf16_t* WT, LAS float* scr, int item, int lane, const float* kscale) {
    const int nblk = N / 32, kb = item / nblk, nb = item % nblk, k0 = 64 * kb, n0 = 32 * nb;
#pragma unroll 8
    for (int i = 0; i < 32; ++i) { const int kk = 2 * i + (lane >> 5); float v = W[(size_t)(k0 + kk) * N + n0 + (lane & 31)]; if (MODE == 1) v *= kscale[k0 + kk]; scr[kk * 33 + (lane & 31)] = v; }
    LDS_WAIT();
    int r0 = n0;
    if (MODE == 1) { if (n0 < DFF) r0 = (n0 >> 7) * 256 + (n0 & 127); else { const int n2 = n0 - DFF; r0 = (n2 >> 7) * 256 + 128 + (n2 & 127); } }
    const int c = lane & 7;
#pragma unroll
    for (int j = 0; j < 4; ++j) { const int n = (lane >> 3) + 8 * j; const LAS float* s = scr + (8 * c) * 33 + n;
        u32x4 o; o.x = cvt_pk_bf16(s[0 * 33], s[1 * 33]); o.y = cvt_pk_bf16(s[2 * 33], s[3 * 33]); o.z = cvt_pk_bf16(s[4 * 33], s[5 * 33]); o.w = cvt_pk_bf16(s[6 * 33], s[7 * 33]);
        *(u32x4*)(WT + (size_t)(r0 + n) * K + k0 + 8 * c) = o; }
    LDS_WAIT();
}
__device__ __forceinline__ void rms_row_to_bf16(const float* xrow, const float* gain, bf16_t* orow, int lane) {
    const f32x4* xr = (const f32x4*)xrow + lane; const f32x4* gr = (const f32x4*)gain + lane;
    f32x4 v[4]; float s = 0.f;
#pragma unroll
    for (int j = 0; j < 4; ++j) { v[j] = xr[64 * j]; s += (v[j].x * v[j].x + v[j].y * v[j].y) + (v[j].z * v[j].z + v[j].w * v[j].w); }
    const float rstd = __builtin_amdgcn_rsqf(wave_sum(s) * (1.f / 1024.f) + EPS);
    u32x2* o8 = (u32x2*)orow + lane;
#pragma unroll
    for (int j = 0; j < 4; ++j) { const f32x4 g = gr[64 * j]; u32x2 w; w.x = cvt_pk_bf16(v[j].x * rstd * g.x, v[j].y * rstd * g.y); w.y = cvt_pk_bf16(v[j].z * rstd * g.z, v[j].w * rstd * g.w); o8[64 * j] = w; }
}
__device__ __forceinline__ void rope_entry(int idx, float2* tab) {
    const double INVF[32] = {1.0, 0.7498942093324559, 0.5623413251903491, 0.4216965034285822, 0.31622776601683794, 0.23713737056616552, 0.1778279410038923, 0.1333521432163324, 0.1, 0.07498942093324558, 0.05623413251903491, 0.042169650342858224, 0.03162277660168379, 0.023713737056616554, 0.01778279410038923, 0.01333521432163324, 0.01, 0.007498942093324558, 0.005623413251903491, 0.004216965034285823, 0.0031622776601683794, 0.0023713737056616554, 0.0017782794100389228, 0.001333521432163324, 0.001, 0.0007498942093324559, 0.0005623413251903491, 0.00042169650342858224, 0.00031622776601683794, 0.00023713737056616554, 0.00017782794100389227, 0.0001333521432163324};
    const int pos = idx >> 5, f = idx & 31;
    double invf = 1.0;
#pragma unroll
    for (int i = 0; i < 32; ++i) invf = (f == i) ? INVF[i] : invf;
    const double ang = (double)pos * invf;
    const double k = __builtin_rint(ang * 0.15915494309189535);
    const double r = __builtin_fma(-k, 6.283185307179586, ang);
    const double h = r * 0.25, h2 = h * h;
    double sn = 1.0 / 6227020800.0; sn = sn * h2 - 1.0 / 39916800.0; sn = sn * h2 + 1.0 / 362880.0; sn = sn * h2 - 1.0 / 5040.0; sn = sn * h2 + 1.0 / 120.0; sn = sn * h2 - 1.0 / 6.0; sn = sn * h2 + 1.0; sn *= h;
    double cs = -1.0 / 87178291200.0; cs = cs * h2 + 1.0 / 479001600.0; cs = cs * h2 - 1.0 / 3628800.0; cs = cs * h2 + 1.0 / 40320.0; cs = cs * h2 - 1.0 / 720.0; cs = cs * h2 + 1.0 / 24.0; cs = cs * h2 - 0.5; cs = cs * h2 + 1.0;
    const double s2 = 2.0 * sn * cs, c2 = 1.0 - 2.0 * sn * sn;
    const double s4 = 2.0 * s2 * c2, c4 = 1.0 - 2.0 * s2 * s2;
    tab[idx] = make_float2((float)c4, (float)s4);
}

__device__ __forceinline__ void head_norm_item(bf16_t* base, int ld, const float* gain, const float2* rope_tab, float* kmean_out, LAS float* red, int tid) {
    const int sub = tid & 7, rl = tid >> 3, lane = tid & 63, wave = tid >> 6;
    float gv[8], accm[8];
#pragma unroll
    for (int i = 0; i < 8; ++i) { gv[i] = gain ? gain[sub * 8 + i] : 1.0f; accm[i] = 0.f; }
    u32x4 raw4[4];
#pragma unroll
    for (int pass = 0; pass < 4; ++pass) raw4[pass] = *(const u32x4*)(base + (size_t)(pass * 64 + rl) * ld + sub * 8);
#pragma unroll
    for (int pass = 0; pass < 4; ++pass) {
        const int row = pass * 64 + rl;
        bf16_t* ptr = base + (size_t)row * ld + sub * 8;
        const u32x4 raw = raw4[pass];
        float v[8] = {bf_lo(raw.x), bf_hi(raw.x), bf_lo(raw.y), bf_hi(raw.y), bf_lo(raw.z), bf_hi(raw.z), bf_lo(raw.w), bf_hi(raw.w)};
        float ss = 0.f;
#pragma unroll
        for (int i = 0; i < 8; ++i) ss += v[i] * v[i];
        ss += __shfl_xor(ss, 1); ss += __shfl_xor(ss, 2); ss += __shfl_xor(ss, 4);
        const float r = __builtin_amdgcn_rsqf(ss * (1.f / 64.f) + EPS);
#pragma unroll
        for (int i = 0; i < 8; ++i) v[i] = v[i] * r * gv[i];
        if (rope_tab) {
            const f32x4* t = (const f32x4*)(rope_tab + (size_t)row * 32 + (sub & 3) * 8);
#pragma unroll
            for (int i = 0; i < 4; ++i) { const f32x4 cs = t[i];
                const float p0 = __shfl_xor(v[2 * i], 4), p1 = __shfl_xor(v[2 * i + 1], 4);
                v[2 * i] = (sub < 4) ? (v[2 * i] * cs[0] - p0 * cs[1]) : (v[2 * i] * cs[0] + p0 * cs[1]);
                v[2 * i + 1] = (sub < 4) ? (v[2 * i + 1] * cs[2] - p1 * cs[3]) : (v[2 * i + 1] * cs[2] + p1 * cs[3]); }
        }
        u32x4 w; w.x = cvt_pk_bf16(v[0], v[1]); w.y = cvt_pk_bf16(v[2], v[3]); w.z = cvt_pk_bf16(v[4], v[5]); w.w = cvt_pk_bf16(v[6], v[7]);
        *(u32x4*)ptr = w;
#pragma unroll
        for (int i = 0; i < 8; ++i) accm[i] += v[i];
    }
    if (kmean_out) {
#pragma unroll
        for (int i = 0; i < 8; ++i) { accm[i] += __shfl_xor(accm[i], 8); accm[i] += __shfl_xor(accm[i], 16); accm[i] += __shfl_xor(accm[i], 32); }
        if (lane < 8) {
#pragma unroll
            for (int i = 0; i < 8; ++i) red[wave * 64 + sub * 8 + i] = accm[i]; }
        __syncthreads();
        if (tid < 64) { float s = 0.f;
#pragma unroll
            for (int w = 0; w < 8; ++w) s += red[w * 64 + tid];
            kmean_out[tid] = s * (1.f / 256.f); }
        __syncthreads();
    }
}
__device__ __forceinline__ void transpose_item256(const bf16_t* src, int ld, bf16_t* dst, size_t dpitch, LAS unsigned short* tile, int tid) {
#pragma unroll
    for (int pass = 0; pass < 4; ++pass) { const int row = pass * 64 + (tid >> 3), sub = tid & 7;
        const u32x4 raw = *(const u32x4*)(src + (size_t)row * ld + sub * 8);
        LAS unsigned* t32 = (LAS unsigned*)(tile + row * 66 + sub * 8); t32[0] = raw.x; t32[1] = raw.y; t32[2] = raw.z; t32[3] = raw.w; }
    __syncthreads();
    const int d = tid & 63, chunk = tid >> 6;
#pragma unroll
    for (int c4 = 0; c4 < 4; ++c4) { const int t0 = chunk * 32 + c4 * 8; unsigned w[4];
#pragma unroll
        for (int i = 0; i < 4; ++i) { const unsigned lo = tile[(t0 + 2 * i) * 66 + d], hi = tile[(t0 + 2 * i + 1) * 66 + d]; w[i] = lo | (hi << 16); }
        u32x4 o; o.x = w[0]; o.y = w[1]; o.z = w[2]; o.w = w[3];
        *(u32x4*)(dst + (size_t)d * dpitch + t0) = o; }
    __syncthreads();
}

__device__ __forceinline__ f32x4 mfma16(bf16x8 a, bf16x8 b, f32x4 c) { return __builtin_amdgcn_mfma_f32_16x16x32_bf16(a, b, c, 0, 0, 0); }
constexpr int KPB = 160;
template <int NK> __device__ __forceinline__ void stage_k(LAS unsigned char* Kt, const bf16_t* src, int ld, int tid) {
#pragma unroll
    for (int i = 0; i < NK / 64; ++i) { const int row = i * 64 + (tid >> 3), ch = tid & 7;
        const u32x4 v = *(const u32x4*)(src + (size_t)row * ld + ch * 8);
        *(LAS u32x4*)(Kt + row * KPB + ch * 16) = v; }
}
template <int NK> __device__ __forceinline__ void stage_vt(LAS unsigned char* Vt, const bf16_t* src, size_t gp, int tid) {
    constexpr int CPR = NK / 8, RPP = 512 / CPR, VPB = NK * 2 + 16;
#pragma unroll
    for (int i = 0; i < 64 / RPP; ++i) { const int d = i * RPP + tid / CPR, ch = tid % CPR;
        const u32x4 v = *(const u32x4*)(src + (size_t)d * gp + ch * 8);
        *(LAS u32x4*)(Vt + d * VPB + ch * 16) = v; }
}
template <int NK> struct StageRegs { u32x4 k[NK / 64]; u32x4 v[NK / 64]; };
template <int NK> __device__ __forceinline__ void stage_load(StageRegs<NK>& r, const bf16_t* ksrc, int ld, const bf16_t* vsrc, size_t gp, int tid) {
    constexpr int CPR = NK / 8, RPP = 512 / CPR;
#pragma unroll
    for (int i = 0; i < NK / 64; ++i) { const int row = i * 64 + (tid >> 3), ch = tid & 7; r.k[i] = *(const u32x4*)(ksrc + (size_t)row * ld + ch * 8); }
#pragma unroll
    for (int i = 0; i < 64 / RPP; ++i) { const int d = i * RPP + tid / CPR, ch = tid % CPR; r.v[i] = *(const u32x4*)(vsrc + (size_t)d * gp + ch * 8); }
}
template <int NK> __device__ __forceinline__ void stage_store(const StageRegs<NK>& r, LAS unsigned char* Kt, LAS unsigned char* Vt, int tid) {
    constexpr int CPR = NK / 8, RPP = 512 / CPR, VPB = NK * 2 + 16;
#pragma unroll
    for (int i = 0; i < NK / 64; ++i) { const int row = i * 64 + (tid >> 3), ch = tid & 7; *(LAS u32x4*)(Kt + row * KPB + ch * 16) = r.k[i]; }
#pragma unroll
    for (int i = 0; i < 64 / RPP; ++i) { const int d = i * RPP + tid / CPR, ch = tid % CPR; *(LAS u32x4*)(Vt + d * VPB + ch * 16) = r.v[i]; }
}
__device__ __forceinline__ bf16x8 kfrag(const LAS unsigned char* Kt, int kt, int ks, int lr, int g) { return *(const LAS bf16x8*)(Kt + (kt * 16 + lr) * KPB + ks * 64 + g * 16); }
template <int VPB> __device__ __forceinline__ bf16x8 vfrag(const LAS unsigned char* Vt, int dt, int keybase, int lr, int g) {
    const LAS unsigned char* p = Vt + (16 * dt + lr) * VPB + (keybase + 4 * g) * 2;
    const u32x2 lo = *(const LAS u32x2*)p, hi = *(const LAS u32x2*)(p + 32);
    u32x4 w; w.x = lo.x; w.y = lo.y; w.z = hi.x; w.w = hi.y; return __builtin_bit_cast(bf16x8, w);
}
__device__ __forceinline__ bf16x8 pack_p(const f32x4 a, const f32x4 b) { u32x4 w; w.x = cvt_pk_bf16(a[0], a[1]); w.y = cvt_pk_bf16(a[2], a[3]); w.z = cvt_pk_bf16(b[0], b[1]); w.w = cvt_pk_bf16(b[2], b[3]); return __builtin_bit_cast(bf16x8, w); }
__device__ __forceinline__ void store_o16(LAS unsigned char* scr, const f32x4 (&o)[4], bf16_t* gbase, int lane) {
    const int lr = lane & 15, g = lane >> 4;
#pragma unroll
    for (int dt = 0; dt < 4; ++dt)
#pragma unroll
        for (int j = 0; j < 4; ++j) *(LAS unsigned short*)(scr + (4 * g + j) * 144 + (16 * dt + lr) * 2) = (unsigned short)(cvt_pk_bf16(o[dt][j], 0.f) & 0xffffu);
    LDS_WAIT();
#pragma unroll
    for (int c = 0; c < 2; ++c) { const int idx = lane + 64 * c, row = idx >> 3, ch = idx & 7;
        const u32x4 v = *(const LAS u32x4*)(scr + row * 144 + ch * 16);
        *(u32x4*)(gbase + (size_t)row * DM + ch * 8) = v; }
    LDS_WAIT();
}
__device__ __forceinline__ void load_qfrag(bf16x8 (&qf)[2], const bf16_t* qrow, int g) { qf[0] = *(const bf16x8*)(qrow + g * 8); qf[1] = *(const bf16x8*)(qrow + 32 + g * 8); }

__device__ __forceinline__ void sb_unit(LAS unsigned char* lds, const bf16_t* QKV, const bf16_t* SBVT, bf16_t* O, int b, int h, int qt, int tid) {
    constexpr int VPB = 128 * 2 + 16;
    LAS unsigned char* Kt = lds; LAS unsigned char* Vt = lds + 128 * KPB;
    const int lane = tid & 63, w = tid >> 6, lr = lane & 15, g = lane >> 4;
    const int t0 = qt * 128; const size_t rowbase = (size_t)b * S;
    bf16x8 qf[2]; load_qfrag(qf, QKV + (rowbase + t0 + 16 * w + lr) * QKVW + C_SBQ + h * 64, g);
    f32x4 o[4];
#pragma unroll
    for (int dt = 0; dt < 4; ++dt) o[dt] = (f32x4){0.f, 0.f, 0.f, 0.f};
    float R = 1.f; bool wdone = false;
    LAS int* dflag = (LAS int*)(lds + 59392);
    int itp = 0;
    const int tl = 16 * w + lr;
    const bf16_t* ksb = QKV + rowbase * QKVW + C_SBK + h * 64; const bf16_t* vsb = SBVT + ((size_t)(b * 6 + h) * 64) * S;
    StageRegs<128> sr; stage_load<128>(sr, ksb + (size_t)qt * 128 * QKVW, QKVW, vsb + (size_t)qt * 128, S, tid);
    for (int kb = qt; kb >= 0; --kb) {
        stage_store<128>(sr, Kt, Vt, tid);
        if (kb > 0) stage_load<128>(sr, ksb + (size_t)(kb - 1) * 128 * QKVW, QKVW, vsb + (size_t)(kb - 1) * 128, S, tid);
        BAR_LDS();
        if (!wdone) {
            const int lim = (kb == qt) ? tl : 4096;
            const int ktmax = (kb == qt) ? __builtin_amdgcn_readfirstlane(w) : 7;
            f32x4 p[8];
#pragma unroll
            for (int kt = 0; kt < 8; ++kt) { f32x4 s = (f32x4){0.f, 0.f, 0.f, 0.f};
                if (kt <= ktmax) { s = mfma16(kfrag(Kt, kt, 0, lr, g), qf[0], s); s = mfma16(kfrag(Kt, kt, 1, lr, g), qf[1], s); }
                p[kt] = s; if (kt & 1) asm volatile("" ::: "memory"); }
#pragma unroll
            for (int kt = 7; kt >= 0; --kt) {
                if (kt <= ktmax) {
                    float bt[4], om[4];
#pragma unroll
                    for (int j = 0; j < 4; ++j) { const float y = p[kt][j] * SC2; const float e = __builtin_amdgcn_exp2f(-fabsf(y)); const float r = __builtin_amdgcn_rcpf(1.0f + e); const float er = e * r;
                        const bool valid = (kt * 16 + 4 * g + j) < lim; const bool pos = y >= 0.f;
                        bt[j] = valid ? (pos ? r : er) : 0.f; om[j] = valid ? (pos ? er : r) : 1.f; }
                    const float suf2 = om[3], suf1 = om[3] * om[2], suf0 = suf1 * om[1], T = suf0 * om[0];
                    const float x1 = __shfl_xor(T, 16); const float a_ = T * x1; const float x2 = __shfl_xor(a_, 32); const float tot = a_ * x2;
                    const float above = (g == 0) ? (x1 * x2) : (g == 1) ? x2 : (g == 2) ? x1 : 1.f;
                    const float bs = R * above;
                    p[kt][0] = bt[0] * (bs * suf0); p[kt][1] = bt[1] * (bs * suf1); p[kt][2] = bt[2] * (bs * suf2); p[kt][3] = bt[3] * bs;
                    R *= tot;
                }
            }
#pragma unroll
            for (int i = 0; i < 4; ++i) { const bf16x8 a = pack_p(p[2 * i], p[2 * i + 1]);
#pragma unroll
                for (int dt = 0; dt < 4; ++dt) o[dt] = mfma16(a, vfrag<VPB>(Vt, dt, 32 * i, lr, g), o[dt]);
                asm volatile("" ::: "memory"); }
#ifndef SB_NOEXIT
            wdone = __all(R == 0.0f);
#endif
        }
        if (lane == 0) dflag[itp * 8 + w] = wdone ? 1 : 0;
        BAR_LDS();
        { const int f = dflag[itp * 8 + (lane & 7)]; itp ^= 1; if (__all(f != 0)) break; }
    }
    store_o16(lds + 40960 + w * 2304, o, O + (rowbase + t0 + 16 * w) * DM + h * 64, lane);
    __syncthreads();
}

__device__ __forceinline__ void softmax256(f32x4 (&s)[16], float& mx, float& sum) {
    float m = -INFINITY;
#pragma unroll
    for (int kt = 0; kt < 16; ++kt) m = fmaxf(m, fmaxf(fmaxf(s[kt][0], s[kt][1]), fmaxf(s[kt][2], s[kt][3])));
    m = fmaxf(m, __shfl_xor(m, 16)); m = fmaxf(m, __shfl_xor(m, 32));
    const float ms = m * SC2; float l = 0.f;
#pragma unroll
    for (int kt = 0; kt < 16; ++kt)
#pragma unroll
        for (int j = 0; j < 4; ++j) { const float e = __builtin_amdgcn_exp2f(s[kt][j] * SC2 - ms); s[kt][j] = e; l += e; }
    l += __shfl_xor(l, 16); l += __shfl_xor(l, 32);
    mx = ms; sum = l;
}

__device__ __forceinline__ void moba_select_unit(LAS unsigned char* lds, const bf16_t* QKV, const float* KMEAN, unsigned* SEL, int b, int h, int jb, int tid) {
    LAS float* kmb = (LAS float*)lds;
    { const float* src = KMEAN + (size_t)((b * 6 + h) * 32) * 64; for (int i = tid; i < jb * 64; i += 512) kmb[i] = src[i]; }
    __syncthreads();
    {
        const int q = tid >> 1, hf = tid & 1;
        float qv[32];
        const bf16_t* qr = QKV + ((size_t)b * S + (size_t)jb * 256 + q) * QKVW + C_MOQ + h * 64 + hf * 32;
#pragma unroll
        for (int c = 0; c < 4; ++c) { const u32x4 raw = *(const u32x4*)(qr + c * 8); qv[c * 8 + 0] = bf_lo(raw.x); qv[c * 8 + 1] = bf_hi(raw.x); qv[c * 8 + 2] = bf_lo(raw.y); qv[c * 8 + 3] = bf_hi(raw.y);
            qv[c * 8 + 4] = bf_lo(raw.z); qv[c * 8 + 5] = bf_hi(raw.z); qv[c * 8 + 6] = bf_lo(raw.w); qv[c * 8 + 7] = bf_hi(raw.w); }
        float v1 = -INFINITY, v2 = -INFINITY, v3 = -INFINITY; unsigned i1 = 255u, i2 = 255u, i3 = 255u;
        const LAS float* km = kmb + hf * 32;
        for (int n = 0; n < jb; ++n) {
            float d0 = 0.f, d1 = 0.f, d2 = 0.f, d3 = 0.f;
#pragma unroll
            for (int c = 0; c < 8; ++c) { const f32x4 kv = *(const LAS f32x4*)(km + n * 64 + c * 4); d0 += qv[c * 4] * kv[0]; d1 += qv[c * 4 + 1] * kv[1]; d2 += qv[c * 4 + 2] * kv[2]; d3 += qv[c * 4 + 3] * kv[3]; }
            float gt = (d0 + d1) + (d2 + d3);
            gt += __shfl_xor(gt, 1);
            if (gt > v1) { v3 = v2; i3 = i2; v2 = v1; i2 = i1; v1 = gt; i1 = (unsigned)n; }
            else if (gt > v2) { v3 = v2; i3 = i2; v2 = gt; i2 = (unsigned)n; }
            else if (gt > v3) { v3 = gt; i3 = (unsigned)n; }
        }
        if (hf == 0) SEL[(size_t)(b * 6 + h) * S + (size_t)jb * 256 + q] = i1 | (i2 << 8) | (i3 << 16);
    }
    __syncthreads();
}

template <bool MASKED, int VPB>
__device__ __forceinline__ void kv_tile(const LAS unsigned char* Kt, const LAS unsigned char* Vt, const bf16x8 (&qf)[2], int qlim, float mx, int lr, int g, float& sum_out, f32x4 (&o)[4]) {
    float sum = 0.f;
#pragma unroll
    for (int dt = 0; dt < 4; ++dt) o[dt] = (f32x4){0.f, 0.f, 0.f, 0.f};
#pragma unroll
    for (int hf = 0; hf < 2; ++hf) {
        f32x4 s[8];
#pragma unroll
        for (int k8 = 0; k8 < 8; ++k8) { const int kt = hf * 8 + k8;
            f32x4 a = (f32x4){0.f, 0.f, 0.f, 0.f}; a = mfma16(kfrag(Kt, kt, 0, lr, g), qf[0], a); a = mfma16(kfrag(Kt, kt, 1, lr, g), qf[1], a);
#pragma unroll
            for (int j = 0; j < 4; ++j) { float e = __builtin_amdgcn_exp2f(a[j] * SC2 - mx); if (MASKED) e = (kt * 16 + 4 * g + j > qlim) ? 0.f : e; a[j] = e; sum += e; }
            s[k8] = a;
            if ((k8 & 3) == 3) asm volatile("" ::: "memory"); }
#pragma unroll
        for (int i = 0; i < 4; ++i) { const bf16x8 a = pack_p(s[2 * i], s[2 * i + 1]);
#pragma unroll
            for (int dt = 0; dt < 4; ++dt) o[dt] = mfma16(a, vfrag<VPB>(Vt, dt, 128 * hf + 32 * i, lr, g), o[dt]);
            if (i & 1) asm volatile("" ::: "memory"); }
    }
    sum += __shfl_xor(sum, 16); sum += __shfl_xor(sum, 32);
    sum_out = sum;
}

template <int VPB, bool MASKED = false>
__device__ __forceinline__ void kv_tile2(const LAS unsigned char* Kt, const LAS unsigned char* Vt, const bf16x8 (&qa)[2], const bf16x8 (&qb)[2], float mx, int lr, int g,
                                         float& suma_out, float& sumb_out, f32x4 (&oa)[4], f32x4 (&ob)[4], int qlima = 4096, int qlimb = 4096) {
    float suma = 0.f, sumb = 0.f;
#pragma unroll
    for (int dt = 0; dt < 4; ++dt) { oa[dt] = (f32x4){0.f, 0.f, 0.f, 0.f}; ob[dt] = (f32x4){0.f, 0.f, 0.f, 0.f}; }
#pragma unroll
    for (int q4 = 0; q4 < 4; ++q4) {
        f32x4 sa[4], sb[4];
#pragma unroll
        for (int k4 = 0; k4 < 4; ++k4) { const int kt = q4 * 4 + k4;
            const bf16x8 k0 = kfrag(Kt, kt, 0, lr, g), k1 = kfrag(Kt, kt, 1, lr, g);
            f32x4 a = (f32x4){0.f, 0.f, 0.f, 0.f}, b = (f32x4){0.f, 0.f, 0.f, 0.f};
            a = mfma16(k0, qa[0], a); b = mfma16(k0, qb[0], b); a = mfma16(k1, qa[1], a); b = mfma16(k1, qb[1], b);
#pragma unroll
            for (int j = 0; j < 4; ++j) { float ea = __builtin_amdgcn_exp2f(a[j] * SC2 - mx), eb = __builtin_amdgcn_exp2f(b[j] * SC2 - mx);
                if (MASKED) { ea = (kt * 16 + 4 * g + j > qlima) ? 0.f : ea; eb = (kt * 16 + 4 * g + j > qlimb) ? 0.f : eb; }
                a[j] = ea; b[j] = eb; suma += ea; sumb += eb; }
            sa[k4] = a; sb[k4] = b; }
        asm volatile("" ::: "memory");
#pragma unroll
        for (int i = 0; i < 2; ++i) { const bf16x8 pa = pack_p(sa[2 * i], sa[2 * i + 1]), pb = pack_p(sb[2 * i], sb[2 * i + 1]);
#pragma unroll
            for (int dt = 0; dt < 4; ++dt) { const bf16x8 vf = vfrag<VPB>(Vt, dt, 64 * q4 + 32 * i, lr, g); oa[dt] = mfma16(pa, vf, oa[dt]); ob[dt] = mfma16(pb, vf, ob[dt]); } }
        asm volatile("" ::: "memory");
    }
    suma += __shfl_xor(suma, 16); suma += __shfl_xor(suma, 32); sumb += __shfl_xor(sumb, 16); sumb += __shfl_xor(sumb, 32);
    suma_out = suma; sumb_out = sumb;
}

__device__ __forceinline__ void mem_unit(LAS unsigned char* lds, const bf16_t* QKV, const bf16_t* MEMKV, const bf16_t* MEMVT, bf16_t* O, const float* gq, const float* gk, int b, int h, int qc, int tid) {
    constexpr int VPB = 256 * 2 + 16;
    LAS unsigned char* Kt = lds; LAS unsigned char* Vt = lds + 256 * KPB;
    const int lane = tid & 63, w = tid >> 6, lr = lane & 15, g = lane >> 4;
    LAS unsigned char* oscr = lds + 77824 + w * 2560; LAS float* rinv = (LAS float*)(oscr + 2304);
    float mx; { float a = fabsf(gq[lane]), c = fabsf(gk[lane]);
#pragma unroll
        for (int o_ = 1; o_ < 64; o_ <<= 1) { a = fmaxf(a, __shfl_xor(a, o_)); c = fmaxf(c, __shfl_xor(c, o_)); }
        mx = 64.0f * a * c * SC2; }
    bf16x8 qa[2], qb[2];
    { const size_t r0_ = (size_t)b * S + qc * 256 + 16 * w; load_qfrag(qa, QKV + (r0_ + lr) * QKVW + C_MEQ + h * 64, g); load_qfrag(qb, QKV + (r0_ + 128 + lr) * QKVW + C_MEQ + h * 64, g); }
    stage_k<256>(Kt, MEMKV + (size_t)(b * MEML) * 512 + h * 64, 512, tid);
    stage_vt<256>(Vt, MEMVT + (size_t)((b * 4 + h) * 64) * MEML, MEML, tid);
    __syncthreads();
    LAS float* rinv2 = rinv + 16;
    {
        const size_t row0 = (size_t)b * S + qc * 256 + 16 * w, row1 = row0 + 128;
        float suma, sumb; f32x4 oa[4], ob[4];
        kv_tile2<VPB>(Kt, Vt, qa, qb, mx, lr, g, suma, sumb, oa, ob);
        if (g == 0) { rinv[lr] = 1.0f / suma; rinv2[lr] = 1.0f / sumb; }
        LDS_WAIT();
#pragma unroll
        for (int j = 0; j < 4; ++j) { const float iva = rinv[4 * g + j], ivb = rinv2[4 * g + j];
#pragma unroll
            for (int dt = 0; dt < 4; ++dt) { oa[dt][j] *= iva; ob[dt][j] *= ivb; } }
        store_o16(oscr, oa, O + row0 * DM + 768 + h * 64, lane);
        store_o16(oscr, ob, O + row1 * DM + 768 + h * 64, lane);
    }
    __syncthreads();
}

__device__ __forceinline__ void kv_write(LAS unsigned char* oscr, LAS int* rowid, const f32x4 (&o)[4], float sum, float mx, int pid, bf16_t* PO, float* PML, int lane) {
    const int lr = lane & 15, g = lane >> 4;
    if (g == 0) { rowid[lr] = pid; if (pid >= 0) { PML[(size_t)pid * 2] = mx; PML[(size_t)pid * 2 + 1] = sum; } }
#pragma unroll
    for (int dt = 0; dt < 4; ++dt)
#pragma unroll
        for (int j = 0; j < 4; ++j) *(LAS unsigned short*)(oscr + (4 * g + j) * 144 + (16 * dt + lr) * 2) = (unsigned short)(cvt_pk_bf16(o[dt][j], 0.f) & 0xffffu);
    LDS_WAIT();
#pragma unroll
    for (int c = 0; c < 2; ++c) { const int idx = lane + 64 * c, row = idx >> 3, ch = idx & 7; const int rp = rowid[row];
        const u32x4 v = *(const LAS u32x4*)(oscr + row * 144 + ch * 16);
        if (rp >= 0) *(u32x4*)(PO + (size_t)rp * 64 + ch * 8) = v; }
    LDS_WAIT();
}

__device__ __forceinline__ void moba_kv_unit(LAS unsigned char* lds, const bf16_t* QKV, const bf16_t* MOVT, const unsigned* SEL, bf16_t* PO, float* PML, const float* gq, const float* gk, int b, int h, int n, int tid) {
    constexpr int VPB = 256 * 2 + 16;
    LAS unsigned char* Kt = lds; LAS unsigned char* Vt = lds + 256 * KPB;
    LAS unsigned short* list = (LAS unsigned short*)(lds + 74752);
    LAS int* cntp = (LAS int*)(lds + 90624);
    const int lane = tid & 63, w = tid >> 6, lr = lane & 15, g = lane >> 4;
    LAS unsigned char* oscr = lds + 94208 + w * 2560;
    LAS int* rowid = (LAS int*)(oscr + 2304);
    const size_t rowbase = (size_t)b * S; const int bh = b * 6 + h;
    float mx; { float a = fabsf(gq[lane]), c = fabsf(gk[lane]);
#pragma unroll
        for (int o_ = 1; o_ < 64; o_ <<= 1) { a = fmaxf(a, __shfl_xor(a, o_)); c = fmaxf(c, __shfl_xor(c, o_)); }
        mx = 64.0f * a * c * SC2; }
    bf16x8 qown[4];
    { const bf16_t* q0_ = QKV + (rowbase + (size_t)n * 256 + 16 * w + lr) * QKVW + C_MOQ + h * 64; bf16x8 t0_[2], t1_[2]; load_qfrag(t0_, q0_, g); load_qfrag(t1_, q0_ + (size_t)128 * QKVW, g); qown[0] = t0_[0]; qown[1] = t0_[1]; qown[2] = t1_[0]; qown[3] = t1_[1]; }
    stage_k<256>(Kt, QKV + (rowbase + (size_t)n * 256) * QKVW + C_MOK + h * 64, QKVW, tid);
    stage_vt<256>(Vt, MOVT + ((size_t)bh * 64) * S + (size_t)n * 256, S, tid);
    if (tid == 0) *cntp = 0;
    __syncthreads();
    { const unsigned* selrow = SEL + (size_t)bh * S;
      for (int base = (n + 1) * 256 + w * 64; base < S; base += 512) {
          const int sq = base + lane; const unsigned sv = selrow[sq];
          int slot = -1; if ((sv & 255u) == (unsigned)n) slot = 0; else if (((sv >> 8) & 255u) == (unsigned)n) slot = 1; else if (((sv >> 16) & 255u) == (unsigned)n) slot = 2;
          const bool f = slot >= 0; const unsigned long long mk = __ballot(f);
          int pos0 = 0; if (lane == 0 && mk != 0ull) pos0 = atomicAdd((int*)cntp, (int)__popcll(mk));
          pos0 = __shfl(pos0, 0);
          if (f) list[pos0 + __popcll(mk & ((1ull << lane) - 1ull))] = (unsigned short)(sq | (slot << 13)); } }
    __syncthreads();
    const int cnt = *cntp; const int total = 16 + ((cnt + 15) >> 4);
    const bf16_t* Qb = QKV + rowbase * QKVW + C_MOQ + h * 64;
    { const int sqa = n * 256 + 16 * w + lr, sqb = sqa + 128;
      bf16x8 qa[2] = {qown[0], qown[1]}, qb[2] = {qown[2], qown[3]};
      float suma, sumb; f32x4 oa[4], ob[4];
      kv_tile2<VPB, true>(Kt, Vt, qa, qb, mx, lr, g, suma, sumb, oa, ob, 16 * w + lr, 16 * w + 128 + lr);
      kv_write(oscr, rowid, oa, suma, mx, ((bh * S + sqa) << 2) + 3, PO, PML, lane);
      kv_write(oscr, rowid, ob, sumb, mx, ((bh * S + sqb) << 2) + 3, PO, PML, lane); }
#define KV_PAIR_FETCH(T_, ENTA_, ENTB_, VA_, VB_, QA_, QB_) do { const int ea_ = 16 * ((T_) - 16) + lr, eb_ = ea_ + 128; VA_ = ea_ < cnt; VB_ = eb_ < cnt; \
        ENTA_ = VA_ ? (unsigned)list[ea_] : 0u; ENTB_ = VB_ ? (unsigned)list[eb_] : 0u; \
        load_qfrag(QA_, Qb + (size_t)(VA_ ? (int)(ENTA_ & 8191u) : n * 256) * QKVW, g); load_qfrag(QB_, Qb + (size_t)(VB_ ? (int)(ENTB_ & 8191u) : n * 256) * QKVW, g); } while (0)
    unsigned enta = 0u, entb = 0u; bool va = false, vb = false; bf16x8 qa[2] = {}, qb[2] = {};
    if (16 + w < total) KV_PAIR_FETCH(16 + w, enta, entb, va, vb, qa, qb);
    for (int tile = 16 + w; tile < total; tile += 16) {
        unsigned entan = 0u, entbn = 0u; bool van = false, vbn = false; bf16x8 qan[2] = {}, qbn[2] = {};
        if (tile + 16 < total) KV_PAIR_FETCH(tile + 16, entan, entbn, van, vbn, qan, qbn);
        float suma, sumb; f32x4 oa[4], ob[4];
        kv_tile2<VPB>(Kt, Vt, qa, qb, mx, lr, g, suma, sumb, oa, ob);
        kv_write(oscr, rowid, oa, suma, mx, va ? (((bh * S + (int)(enta & 8191u)) << 2) + (int)(enta >> 13)) : -1, PO, PML, lane);
        kv_write(oscr, rowid, ob, sumb, mx, vb ? (((bh * S + (int)(entb & 8191u)) << 2) + (int)(entb >> 13)) : -1, PO, PML, lane);
        qa[0] = qan[0]; qa[1] = qan[1]; qb[0] = qbn[0]; qb[1] = qbn[1]; enta = entan; entb = entbn; va = van; vb = vbn;
    }
#undef KV_PAIR_FETCH
    __syncthreads();
}

__device__ __forceinline__ void moba_combine(const bf16_t* PO, const float* PML, bf16_t* O, int item) {
    const int ch = item & 7, qid = item >> 3;
    const int bh = qid >> 13, sq = qid & 8191, b = bh / 6, h = bh - b * 6, jb = sq >> 8;
    const int np = jb < 3 ? jb : 3;
    const float2* ml = (const float2*)PML + (size_t)qid * 4;
    const float2 own = ml[3]; float2 pr[3]; float mxx = own.x;
#pragma unroll
    for (int c = 0; c < 3; ++c) { pr[c] = (c < np) ? ml[c] : make_float2(-INFINITY, 0.f); mxx = fmaxf(mxx, pr[c].x); }
    float num[8], den;
    { const float wgt = __builtin_amdgcn_exp2f(own.x - mxx); den = wgt * own.y; const u32x4 v = *(const u32x4*)(PO + ((size_t)qid * 4 + 3) * 64 + ch * 8);
      num[0] = wgt * bf_lo(v.x); num[1] = wgt * bf_hi(v.x); num[2] = wgt * bf_lo(v.y); num[3] = wgt * bf_hi(v.y); num[4] = wgt * bf_lo(v.z); num[5] = wgt * bf_hi(v.z); num[6] = wgt * bf_lo(v.w); num[7] = wgt * bf_hi(v.w); }
#pragma unroll
    for (int c = 0; c < 3; ++c) if (c < np) { const float wgt = __builtin_amdgcn_exp2f(pr[c].x - mxx); den += wgt * pr[c].y; const u32x4 v = *(const u32x4*)(PO + ((size_t)qid * 4 + c) * 64 + ch * 8);
        num[0] += wgt * bf_lo(v.x); num[1] += wgt * bf_hi(v.x); num[2] += wgt * bf_lo(v.y); num[3] += wgt * bf_hi(v.y); num[4] += wgt * bf_lo(v.z); num[5] += wgt * bf_hi(v.z); num[6] += wgt * bf_lo(v.w); num[7] += wgt * bf_hi(v.w); }
    const float inv = 1.0f / den;
    u32x4 wv; wv.x = cvt_pk_bf16(num[0] * inv, num[1] * inv); wv.y = cvt_pk_bf16(num[2] * inv, num[3] * inv); wv.z = cvt_pk_bf16(num[4] * inv, num[5] * inv); wv.w = cvt_pk_bf16(num[6] * inv, num[7] * inv);
    *(u32x4*)(O + ((size_t)b * S + sq) * DM + 384 + h * 64 + ch * 8) = wv;
}

#define XB_TMO      128
#define XB_XCNT(j)  (256  + 64 * (j))
#define XB_XSUB(j)  (1280 + 64 * (j))
#define XB_XGEN(j)  (2304 + 64 * (j))
#define XB_TOP      3328
#define XB_TOPGEN   3392
#define XCD_BAR_WORDS 3456
#define XB_SPIN_CAP (1u << 18)

__device__ __forceinline__ unsigned xb_ld(unsigned* p)              { return __hip_atomic_load(p, __ATOMIC_RELAXED, __HIP_MEMORY_SCOPE_AGENT); }
__device__ __forceinline__ unsigned xb_add(unsigned* p, unsigned v) { return __hip_atomic_fetch_add(p, v, __ATOMIC_RELAXED, __HIP_MEMORY_SCOPE_AGENT); }
__device__ __forceinline__ unsigned xb_xcc_id() { return (unsigned)__builtin_amdgcn_s_getreg((3 << 11) | 20) & 0xFu; }
#define XB_SPIN(cond, bar) do { unsigned _sp = 0; while (cond) { __builtin_amdgcn_s_sleep(1); \
    if ((++_sp & 255u) == 0u) { if (xb_ld(&(bar)[XB_TMO])) break; if (_sp > XB_SPIN_CAP) { atomicAdd(&(bar)[XB_TMO], 1u); break; } } } } while (0)

struct XcdBarrier {
    unsigned* bar; unsigned x;
    volatile LAS unsigned* st;
};

__device__ __forceinline__ XcdBarrier xcd_barrier_post(unsigned* bar, volatile LAS unsigned* st) {
    XcdBarrier b; b.bar = bar; b.x = xb_xcc_id(); b.st = st;
    if (threadIdx.x == 0) (void)xb_add(&bar[XB_XCNT(b.x)], 1u);
    return b;
}
__device__ __forceinline__ void xcd_barrier_complete(unsigned* bar, unsigned x, unsigned& nloc, unsigned& nx) {
    const unsigned G = gridDim.x * gridDim.y * gridDim.z;
    unsigned sum, cnt, mine, sp = 0u;
    for (;;) {
        sum = 0u; cnt = 0u; mine = 0u;
#pragma unroll
        for (unsigned j = 0; j < 16; ++j) { const unsigned c = xb_ld(&bar[XB_XCNT(j)]); sum += c; cnt += (c > 0u) ? 1u : 0u; mine = (j == x) ? c : mine; }
        if (sum == G) break;
        __builtin_amdgcn_s_sleep(1);
        if ((++sp & 255u) == 0u) { if (xb_ld(&bar[XB_TMO])) break; if (sp > XB_SPIN_CAP) { atomicAdd(&bar[XB_TMO], 1u); break; } }
    }
    nloc = mine > 0u ? mine : 1u; nx = cnt > 0u ? cnt : 1u;
}

__device__ __forceinline__ void xcd_barrier(const XcdBarrier& b) {
    asm volatile("s_waitcnt vmcnt(0)" ::: "memory");
    __syncthreads();
    if (threadIdx.x == 0) {
        unsigned* bar = b.bar;
        __builtin_amdgcn_s_waitcnt(0);
        unsigned nloc = b.st[0], nx = b.st[1];
        if (nloc == 0u) { xcd_barrier_complete(bar, b.x, nloc, nx); b.st[0] = nloc; b.st[1] = nx; }
        const unsigned old = xb_add(&bar[XB_XSUB(b.x)], 1u);
        const unsigned gen = old / nloc;
        if (old + 1u == (gen + 1u) * nloc) {
            __builtin_amdgcn_fence(__ATOMIC_RELEASE, "agent");
            asm volatile("s_waitcnt vmcnt(0)" ::: "memory");
            const unsigned og = xb_add(&bar[XB_TOP], 1u);
            const unsigned tg = og / nx;
            if (og + 1u == (tg + 1u) * nx) xb_add(&bar[XB_TOPGEN], 1u);
            else XB_SPIN(xb_ld(&bar[XB_TOPGEN]) == tg, bar);
            __builtin_amdgcn_fence(__ATOMIC_ACQUIRE, "agent");
            xb_add(&bar[XB_XGEN(b.x)], 1u);
            asm volatile("s_waitcnt vmcnt(0)" ::: "memory");
        } else {
            XB_SPIN(xb_ld(&bar[XB_XGEN(b.x)]) == gen, bar);
            __builtin_amdgcn_fence(__ATOMIC_ACQUIRE, "agent");
            asm volatile("s_waitcnt vmcnt(0)" ::: "memory");
        }
    }
    __syncthreads();
}

#define GRID_SYNC() xcd_barrier(xbar)
#define GRID_SYNC_CG() do { asm volatile("s_waitcnt vmcnt(0) lgkmcnt(0)" ::: "memory"); __syncthreads(); grid.sync(); if (wave == 0) { __builtin_amdgcn_fence(__ATOMIC_ACQUIRE, "agent"); asm volatile("s_waitcnt vmcnt(0)" ::: "memory"); } __syncthreads(); } while (0)
#define STAGGER(ticks_per_group) do { const unsigned grp_ = (unsigned)(bx >> 3) & 3u; if (grp_ != 0u) { if (tid == 0) { const unsigned long long t0_ = __builtin_amdgcn_s_memrealtime(); \
    while (__builtin_amdgcn_s_memrealtime() - t0_ < (unsigned long long)(grp_ * (ticks_per_group))) __builtin_amdgcn_s_sleep(16); } __syncthreads(); } } while (0)
__global__ void __launch_bounds__(512, 2) hybrid_fwd(Params p) {
    extern __shared__ __attribute__((aligned(16))) unsigned char lds_raw[];
    LAS unsigned char* lds = (LAS unsigned char*)lds_raw;
    cg::grid_group grid = cg::this_grid();
    const int tid = threadIdx.x, lane = tid & 63, wave = __builtin_amdgcn_readfirstlane(tid >> 6);
    const int G = gridDim.x, bx = blockIdx.x;
    unsigned char* ws = p.ws;
    { volatile LAS unsigned* stw = (volatile LAS unsigned*)(lds + LDS_BYTES - 32); if (tid < 4) stw[tid] = 0u; }
    __syncthreads();
    const XcdBarrier xbar = xcd_barrier_post((unsigned*)(ws + WS_BAR), (volatile LAS unsigned*)(lds + LDS_BYTES - 32));
    const float* x = p.in[0];
    bf16_t* XN = (bf16_t*)(ws + WS_XN); bf16_t* QKV = (bf16_t*)(ws + WS_QKV); bf16_t* GATES = (bf16_t*)(ws + WS_GATES);
    bf16_t* MEMN = (bf16_t*)(ws + WS_MEMN); bf16_t* MEMKV = (bf16_t*)(ws + WS_MEMKV); bf16_t* MEMVT = (bf16_t*)(ws + WS_MEMVT);
    bf16_t* SBVT = (bf16_t*)(ws + WS_SBVT); bf16_t* MOVT = (bf16_t*)(ws + WS_MOVT);
    float* SS = (float*)(ws + WS_SS); float* KMEAN = (float*)(ws + WS_KMEAN); float2* ROPE = (float2*)(ws + WS_ROPE);
    unsigned* CTL = (unsigned*)(ws + WS_CTL);
    bf16_t* Win_t = (bf16_t*)(ws + WS_WIN); bf16_t* Wfin_t = (bf16_t*)(ws + WS_WFIN); bf16_t* Wfdn_t = (bf16_t*)(ws + WS_WFDN); bf16_t* Wout_t = (bf16_t*)(ws + WS_WOUT);
    bf16_t* Wupsb_t = (bf16_t*)(ws + WS_WUPSB); bf16_t* Wupmo_t = (bf16_t*)(ws + WS_WUPMO); bf16_t* Wupme_t = (bf16_t*)(ws + WS_WUPME); bf16_t* Wmemkv_t = (bf16_t*)(ws + WS_WMEMKV);
    bf16_t* OB = XN; bf16_t* X1B = XN; bf16_t* MIX = QKV; bf16_t* HB = QKV;

#ifdef TS_PHASE
    unsigned long long ts0 = __builtin_amdgcn_s_memrealtime(), tsave = 0;
    int ts_k = 0;
#define TS_MARK() do { if (ts_k == TS_PHASE) tsave = __builtin_amdgcn_s_memrealtime() - ts0; ++ts_k; } while (0)
#else
#define TS_MARK() do {} while (0)
#endif
#if PHMASK & 1
#ifndef P0REPS
#define P0REPS 1
#endif
    for (int rep0 = 0; rep0 < P0REPS; ++rep0) {
        LAS float* scr = (LAS float*)(lds + wave * 16384);
        const int gw = bx * 8 + wave, NGW = G * 8;
        constexpr int I_IN = 16 * 176, I_FIN = 16 * 176, I_FDN = 44 * 32, I_OUT = 16 * 32, I_USB = 6 * 32, I_UMO = 6 * 32, I_UME = 4 * 32, I_MKV = 16 * 16;
        constexpr int NITEMS = I_IN + I_FIN + I_FDN + I_OUT + I_USB + I_UMO + I_UME + I_MKV;
        for (int it = gw; it < NITEMS; it += NGW) {
            int r = it;
            if (r < I_IN) { p0_transpose_item<0>(p.in[5], 1024, INW, Win_t, scr, r, lane, nullptr); continue; } r -= I_IN;
            if (r < I_FIN) { p0_transpose_item<1>(p.in[15], 1024, INW, Wfin_t, scr, r, lane, p.in[4]); continue; } r -= I_FIN;
            if (r < I_FDN) { p0_transpose_item<0>(p.in[16], DFF, 1024, Wfdn_t, scr, r, lane, nullptr); continue; } r -= I_FDN;
            if (r < I_OUT) { p0_transpose_item<0>(p.in[14], 1024, 1024, Wout_t, scr, r, lane, nullptr); continue; } r -= I_OUT;
            if (r < I_USB) { p0_transpose_item<0>(p.in[11], 384, 1024, Wupsb_t, scr, r, lane, nullptr); continue; } r -= I_USB;
            if (r < I_UMO) { p0_transpose_item<0>(p.in[12], 384, 1024, Wupmo_t, scr, r, lane, nullptr); continue; } r -= I_UMO;
            if (r < I_UME) { p0_transpose_item<0>(p.in[13], 256, 1024, Wupme_t, scr, r, lane, nullptr); continue; } r -= I_UME;
            p0_transpose_item<0>(p.in[6], 1024, 512, Wmemkv_t, scr, r, lane, nullptr);
        }
        for (int m = gw; m < M; m += NGW) rms_row_to_bf16(x + (size_t)m * DM, p.in[2], XN + (size_t)m * DM, lane);
        for (int m = gw; m < NB * MEML; m += NGW) rms_row_to_bf16(p.in[1] + (size_t)m * DM, p.in[3], MEMN + (size_t)m * DM, lane);
        for (int i = bx * 512 + tid; i < S * 32; i += G * 512) rope_entry(i, ROPE);
        for (int i = bx * 512 + tid; i < M; i += G * 512) SS[i] = 0.f;
        if (bx == 0 && tid < 8) CTL[tid] = 0u;
    }
    if (p.ws == nullptr) { GRID_SYNC_CG(); }
    GRID_SYNC(); TS_MARK();
#ifdef XSEAMS
    for (int xs = 0; xs < XSEAMS; ++xs) { GRID_SYNC(); }
#endif

#endif
#if PHMASK & 2
    {
        pg8::Gemm g{XN, Win_t, M, INW, 1024, 1024}; pg8::StaticOrder So; So.init(M, INW, G, bx, WGM_WIDE);
        pg8::EpiProj E{QKV, GATES};
#ifdef STAG1
        STAGGER(STAG1);
#endif
#ifndef P1REPS
#define P1REPS 1
#endif
        pg8::gemm_phase<pg8::EpiProj, pg8::StaticOrder, true, true>(lds, g, So, E);
#if P1REPS == 2
        pg8::gemm_phase<pg8::EpiProj, pg8::StaticOrder, true, true>(lds, g, So, E);
#endif
    }
    GRID_SYNC(); TS_MARK();

#endif
#if PHMASK & 4
    {
        constexpr int N_A = 768, N_B = 768, N_C = 512, N_D = 16, N_E = 768, N_F = 768, N_G = 16;
        constexpr int NIT = N_A + N_B + N_C + N_D + N_E + N_F + N_G;
#ifdef P1BHN
        for (int it = bx; it < N_A + N_B + N_C; it += G) { int r = it;
            if (r < N_A + N_B) { const bool isk = r >= N_A; if (isk) r -= N_A; const int hh = r % 6, blk = (r / 6) % 32, bb = r / 192;
                head_norm_item(QKV + ((size_t)bb * S + blk * 256) * QKVW + (isk ? C_MOK : C_MOQ) + hh * 64, QKVW, nullptr, nullptr, nullptr, (LAS float*)lds, tid); }
            else { r -= N_A + N_B; const int hh = r % 4, blk = (r / 4) % 32, bb = r / 128;
                head_norm_item(QKV + ((size_t)bb * S + blk * 256) * QKVW + C_MEQ + hh * 64, QKVW, nullptr, nullptr, nullptr, (LAS float*)lds, tid); } }
        __syncthreads();
#endif
        pg8::Gemm g2{MEMN, Wmemkv_t, NB * MEML, 512, 1024, 1024}; pg8::StaticOrder S2; S2.init(NB * MEML, 512, G, bx);
        pg8::EpiPlain E2{MEMKV, 512};
        pg8::gemm_phase<pg8::EpiPlain, pg8::StaticOrder, true, true>(lds, g2, S2, E2);
        for (int i = 0; ; ++i) {
            pg8::Unit uu; if (!S2.next(i, uu)) break;
            for (int hh = 0; hh < 4; ++hh) {
                if (uu.pn == 0) head_norm_item(MEMKV + (size_t)(uu.pm * MEML) * 512 + hh * 64, 512, p.in[10], nullptr, nullptr, (LAS float*)lds, tid);
                else transpose_item256(MEMKV + (size_t)(uu.pm * MEML) * 512 + 256 + hh * 64, 512, MEMVT + (size_t)((uu.pm * 4 + hh) * 64) * MEML, MEML, (LAS unsigned short*)lds, tid); }
            __syncthreads();
        }
        LAS unsigned* shu = (LAS unsigned*)(lds + LDS_BYTES - 16);
        constexpr int NQ = N_A + N_B + N_C + N_E + N_F;
        for (;;) {
            __syncthreads();
            if (tid == 0) shu[0] = atomicAdd(CTL + 7, 1u);
            __syncthreads();
            int r = (int)shu[0];
            if (r >= NQ) break;
            if (r < N_A + N_B) { const bool isk = r >= N_A; if (isk) r -= N_A; const int hh = r % 6, blk = (r / 6) % 32, bb = r / 192;
                bf16_t* base = QKV + ((size_t)bb * S + blk * 256) * QKVW + (isk ? C_MOK : C_MOQ) + hh * 64;
                head_norm_item(base, QKVW, isk ? p.in[8] : p.in[7], ROPE + (size_t)blk * 256 * 32, isk ? (KMEAN + (size_t)((bb * 6 + hh) * 32 + blk) * 64) : nullptr, (LAS float*)lds, tid); continue; }
            r -= N_A + N_B;
            if (r < N_C) { const int hh = r % 4, blk = (r / 4) % 32, bb = r / 128;
                head_norm_item(QKV + ((size_t)bb * S + blk * 256) * QKVW + C_MEQ + hh * 64, QKVW, p.in[9], nullptr, nullptr, (LAS float*)lds, tid); continue; }
            r -= N_C;
            { const bool ismo = r >= N_E; if (ismo) r -= N_E; const int hh = r % 6, blk = (r / 6) % 32, bb = r / 192;
                transpose_item256(QKV + ((size_t)bb * S + blk * 256) * QKVW + (ismo ? C_MOV : C_SBV) + hh * 64, QKVW, (ismo ? MOVT : SBVT) + ((size_t)(bb * 6 + hh) * 64) * S + (size_t)blk * 256, S, (LAS unsigned short*)lds, tid); }
        }
    }
    GRID_SYNC(); TS_MARK();

#endif
#if PHMASK & 8
    {
        unsigned* SEL = (unsigned*)(ws + WS_SEL);
        { LAS unsigned* shu = (LAS unsigned*)(lds + LDS_BYTES - 16);
          for (;;) {
              __syncthreads();
              if (tid == 0) shu[0] = atomicAdd(CTL + 6, 1u);
              __syncthreads();
              const int u = (int)shu[0];
              if (u >= 768) break;
              const int jb = 31 - u / 24, bh = u % 24; moba_select_unit(lds, QKV, KMEAN, SEL, bh / 6, bh % 6, jb, tid); } }
    }
    GRID_SYNC();
    {
        const unsigned* SEL = (const unsigned*)(ws + WS_SEL); bf16_t* PO = (bf16_t*)p.out; float* PML = p.out + 25165824 + 1048576;
        LAS unsigned* shu = (LAS unsigned*)(lds + LDS_BYTES - 16);
        constexpr int U_MO = 768, U_SB = 1536, U_ME = 512;
#ifndef UMASK
#define UMASK 7
#endif
#ifndef P2REPS
#define P2REPS 1
#endif
#ifndef R2MASK
#define R2MASK 7
#endif
        for (int rep = 0; rep < P2REPS; ++rep) {
#if UMASK & 1
        if (rep == 0 || (R2MASK & 1)) for (;;) {
            __syncthreads();
            if (tid == 0) shu[0] = atomicAdd(CTL + 3 * rep, 1u);
            __syncthreads();
            const int u = (int)shu[0];
            if (u >= U_MO) break;
            const int nb = u / 24, bh = u % 24; int t2 = tid; asm volatile("" : "+v"(t2)); moba_kv_unit(lds, QKV, MOVT, SEL, PO, PML, p.in[7], p.in[8], bh / 6, bh % 6, nb, t2);
        }
#endif
#if UMASK & 2
        if (rep == 0 || (R2MASK & 2)) for (;;) {
            __syncthreads();
            if (tid == 0) shu[0] = atomicAdd(CTL + 3 * rep + 1, 1u);
            __syncthreads();
            const int v = (int)shu[0];
            if (v >= U_SB) break;
            const int qt = 63 - v / 24, bh = v % 24; int t2 = tid; asm volatile("" : "+v"(t2)); sb_unit(lds, QKV, SBVT, OB, bh / 6, bh % 6, qt, t2);
        }
#endif
#if UMASK & 4
        if (rep == 0 || (R2MASK & 4)) for (;;) {
            __syncthreads();
            if (tid == 0) shu[0] = atomicAdd(CTL + 3 * rep + 2, 1u);
            __syncthreads();
            const int v = (int)shu[0];
            if (v >= U_ME) break;
            const int qc = v / 16, bh = v % 16; int t2 = tid; asm volatile("" : "+v"(t2)); mem_unit(lds, QKV, MEMKV, MEMVT, OB, p.in[9], p.in[10], bh / 4, bh % 4, qc, t2);
        }
#endif
        }
    }
    GRID_SYNC(); TS_MARK();
    {
        const bf16_t* PO = (const bf16_t*)p.out; const float* PML = p.out + 25165824 + 1048576;
#ifndef P2CREPS
#define P2CREPS 1
#endif
        for (int r2c = 0; r2c < P2CREPS; ++r2c)
        for (int it = bx * 512 + tid; it < 24 * S * 8; it += G * 512) moba_combine(PO, PML, OB, it);
    }
    GRID_SYNC();

#endif
#if PHMASK & 16
    {
        pg8::StaticOrder So; So.init(M, 1024, G, bx, WGM_P3);
#ifndef P3MASK
#define P3MASK 7
#endif
        if (P3MASK & 1) { pg8::Gemm g{OB, Wupsb_t, M, 1024, 384, 1024}; pg8::EpiGate<true> E{MIX, GATES, 0}; pg8::gemm_phase<pg8::EpiGate<true>, pg8::StaticOrder, true, true>(lds, g, So, E); }
        if (P3MASK & 2) { pg8::Gemm g{OB + 384, Wupmo_t, M, 1024, 384, 1024}; pg8::EpiGate<false> E{MIX, GATES, 1024}; pg8::gemm_phase<pg8::EpiGate<false>, pg8::StaticOrder, true, true>(lds, g, So, E); }
        if (P3MASK & 4) { pg8::Gemm g{OB + 768, Wupme_t, M, 1024, 256, 1024}; pg8::EpiGate<false> E{MIX, GATES, 2048}; pg8::gemm_phase<pg8::EpiGate<false>, pg8::StaticOrder, true, true>(lds, g, So, E); }
#if defined(P3REPS) && P3REPS == 2
        if (P3MASK & 1) { pg8::Gemm g{OB, Wupsb_t, M, 1024, 384, 1024}; pg8::EpiGate<true> E{MIX, GATES, 0}; pg8::gemm_phase<pg8::EpiGate<true>, pg8::StaticOrder, true, true>(lds, g, So, E); }
        if (P3MASK & 2) { pg8::Gemm g{OB + 384, Wupmo_t, M, 1024, 384, 1024}; pg8::EpiGate<false> E{MIX, GATES, 1024}; pg8::gemm_phase<pg8::EpiGate<false>, pg8::StaticOrder, true, true>(lds, g, So, E); }
        if (P3MASK & 4) { pg8::Gemm g{OB + 768, Wupme_t, M, 1024, 256, 1024}; pg8::EpiGate<false> E{MIX, GATES, 2048}; pg8::gemm_phase<pg8::EpiGate<false>, pg8::StaticOrder, true, true>(lds, g, So, E); }
#endif
    }
    GRID_SYNC(); TS_MARK();

#endif
#if PHMASK & 32
    {
        pg8::Gemm g{MIX, Wout_t, M, 1024, 1024, 1024}; pg8::StaticOrder So; So.init(M, 1024, G, bx, WGM_P4);
#ifdef P4PROBE
        { pg8::EpiPlain Ep{X1B, 1024}; pg8::gemm_phase<pg8::EpiPlain, pg8::StaticOrder, true, true>(lds, g, So, Ep); }
#endif
#ifdef P4EPROBE
        { pg8::EpiRes1 Ep{x, (float*)(ws + 216 * MiB), (bf16_t*)(ws + 344 * MiB), (float*)(ws + 410 * MiB)}; pg8::gemm_phase<pg8::EpiRes1, pg8::StaticOrder, true, true>(lds, g, So, Ep); }
#endif
        pg8::EpiRes1 E{x, p.out, X1B, SS};
        pg8::gemm_phase<pg8::EpiRes1, pg8::StaticOrder, true, true>(lds, g, So, E);
    }
    GRID_SYNC(); TS_MARK();

#endif
#if PHMASK & 64
    {
        pg8::Gemm g{X1B, Wfin_t, M, INW, 1024, 1024}; pg8::StaticOrder So; So.init(M, INW, G, bx, WGM_WIDE);
        pg8::EpiSwiGLU E{HB, SS};
#ifdef STAG5
        STAGGER(STAG5);
#endif
#ifndef P5REPS
#define P5REPS 1
#endif
        pg8::gemm_phase<pg8::EpiSwiGLU, pg8::StaticOrder, true, true>(lds, g, So, E);
#if P5REPS == 2
        pg8::gemm_phase<pg8::EpiSwiGLU, pg8::StaticOrder, true, true>(lds, g, So, E);
#endif
    }
    GRID_SYNC(); TS_MARK();

#endif
#if PHMASK & 128
    {
        pg8::Gemm g{HB, Wfdn_t, M, 1024, DFF, DFF}; pg8::StaticOrder So; So.init(M, 1024, G, bx, WGM_P6);
#ifdef P6PROBE
        { pg8::EpiPlain Ep{X1B, 1024}; pg8::gemm_phase<pg8::EpiPlain, pg8::StaticOrder, true, true>(lds, g, So, Ep); }
#endif
#ifdef P6EPROBE
        { pg8::EpiRes2 Ep{(float*)(ws + 330 * MiB), p.out}; pg8::gemm_phase<pg8::EpiRes2, pg8::StaticOrder, true, true>(lds, g, So, Ep); }
#endif
        pg8::EpiRes2 E{p.out, p.out};
        pg8::gemm_phase<pg8::EpiRes2, pg8::StaticOrder, true, true>(lds, g, So, E);
    }
#endif
#ifdef TS_PHASE
    GRID_SYNC();
    if (bx == 0 && tid == 0) p.out[0] = (float)tsave * 0.01f;
#endif
#ifdef DUMP_OFF
    GRID_SYNC(); TS_MARK();
    { const bf16_t* src = (const bf16_t*)(ws + (size_t)DUMP_OFF * MiB); const size_t N1 = (size_t)M * DM;
      for (size_t i = (size_t)bx * 512 + tid; i < N1; i += (size_t)G * 512) { float a = 0.f;
          for (int k = 0; k < DUMP_NK; ++k) { const unsigned v = src[i + (size_t)k * N1]; a += __uint_as_float(v << 16); }
          p.out[i] = a; } }
#endif
}

extern "C" void kernel_launch(void* const* d_in, const int* in_sizes, int n_in, void* d_out, int out_size, void* d_ws, size_t ws_size, hipStream_t stream) {
    static int grid = 0;
    if (grid == 0) {
        if (n_in != 17 || out_size != M * DM || ws_size < WS_END) { fprintf(stderr, "kernel_launch: unexpected shapes: n_in %d out %d ws %zu (need %zu)\n", n_in, out_size, ws_size, (size_t)WS_END); grid = -1; return; }
        int dev = 0, cus = 0, per_cu = 0;
        hipGetDevice(&dev); hipDeviceGetAttribute(&cus, hipDeviceAttributeMultiprocessorCount, dev);
        if (hipFuncSetAttribute((const void*)hybrid_fwd, hipFuncAttributeMaxDynamicSharedMemorySize, LDS_BYTES) != hipSuccess) { fprintf(stderr, "kernel_launch: hipFuncSetAttribute(%d B LDS) failed\n", LDS_BYTES); }
        if (hipOccupancyMaxActiveBlocksPerMultiprocessor(&per_cu, (const void*)hybrid_fwd, 512, LDS_BYTES) != hipSuccess || per_cu < 1) fprintf(stderr, "kernel_launch: occupancy query says %d blocks/CU\n", per_cu);
        (void)hipGetLastError();
        grid = cus > 0 ? cus : 256;
    }
    if (grid < 0) return;
    Params p{};
    for (int i = 0; i < 17; ++i) p.in[i] = (const float*)d_in[i];
    p.out = (float*)d_out; p.ws = (unsigned char*)d_ws;
    if (hipMemsetAsync((char*)d_ws + WS_BAR, 0, 16 * 1024, stream) != hipSuccess) { fprintf(stderr, "kernel_launch: hipMemsetAsync of the barrier words failed\n"); return; }
    void* args[] = {&p};
    hipError_t e = hipLaunchCooperativeKernel((const void*)hybrid_fwd, dim3(grid), dim3(512), args, LDS_BYTES, stream);
    if (e != hipSuccess) fprintf(stderr, "kernel_launch: cooperative launch failed: %s (grid %d)\n", hipGetErrorString(e), grid);
}
```

```cpp
#include <hip/hip_runtime.h>
#include <hip/hip_cooperative_groups.h>
#include <cstdio>
#include <cstdint>
namespace cg = cooperative_groups;
namespace pg8 {
#define PG8_LAS __attribute__((address_space(3)))
typedef unsigned short bf16_t;
typedef short bf16x8 __attribute__((ext_vector_type(8)));
typedef float f32x4 __attribute__((ext_vector_type(4)));
typedef unsigned u32x4 __attribute__((ext_vector_type(4)));
constexpr int BM = 256, BK = 64, HALF = 128, HTB = HALF * BK * 2  , STAGE_BYTES = 8 * HTB, NXCD = 8;

__host__ __device__ __forceinline__ int lds_byte(int r, int c) { const int st = (r >> 4) * 2 + (c >> 5), rr = r & 15, cc = c & 31, ob = rr * 64 + cc * 2; return st * 1024 + (ob ^ (((ob >> 9) & 1) << 5)); }
__host__ __device__ __forceinline__ void stage_rc(int b, int& R, int& C) { const int st = b / 1024, sb = b % 1024, swz = sb ^ (((sb >> 9) & 1) << 5); R = (st >> 1) * 16 + swz / 64; C = (st & 1) * 32 + (swz % 64) / 2; }
__host__ __device__ __forceinline__ int perm32(int rho) { const int n = rho >> 4, i = rho & 15; return 8 * (i >> 2) + 4 * n + (i & 3); }

struct Unit { int pm, pn; };
struct Gemm { const bf16_t* A; const bf16_t* Bt; int M, N, K, lda; };

struct StaticOrder {
    int nM, nN, nwg, G, c, WGM;
    __host__ __device__ void init(int M, int N, int G_, int c_, int wgm_ = 4) { nM = M / BM; nN = N / BM; nwg = nM * nN; G = G_; c = c_; WGM = wgm_; }
    __host__ __device__ bool next(int i, Unit& u) const {
        const long L = (long)i * G + c; if (L >= nwg) return false;
        int wgid = (int)L; { const int q = nwg / NXCD, r = nwg % NXCD, xcd = wgid % NXCD, off = wgid / NXCD; wgid = (xcd < r ? xcd * (q + 1) : r * (q + 1) + (xcd - r) * q) + off; }
        const int nig = WGM * nN, gid = wgid / nig, fm = gid * WGM, gsz = (nM - fm) < WGM ? (nM - fm) : WGM;
        u.pm = fm + ((wgid % nig) % gsz); u.pn = (wgid % nig) / gsz; return true;
    }
    __device__ __forceinline__ void a_ready(const Unit&) const {}
    __device__ __forceinline__ void done(const Unit&) const {}
};

typedef __bf16 bf16v2_t __attribute__((ext_vector_type(2)));
typedef float f32v2_t __attribute__((ext_vector_type(2)));
__device__ __forceinline__ unsigned cvt_pk_bf16(float lo, float hi) { const f32v2_t v = {lo, hi}; const bf16v2_t b = __builtin_convertvector(v, bf16v2_t); return __builtin_bit_cast(unsigned, b); }
typedef float f32x2 __attribute__((ext_vector_type(2)));

typedef unsigned u32x2 __attribute__((ext_vector_type(2)));
__device__ __forceinline__ float bf_lo(unsigned u) { return __uint_as_float(u << 16); }
__device__ __forceinline__ float bf_hi(unsigned u) { return __uint_as_float(u & 0xffff0000u); }
__device__ __forceinline__ float sigmoidf_(float v) { return __builtin_amdgcn_rcpf(1.0f + __builtin_amdgcn_exp2f(-1.4426950408889634f * v)); }

struct EpiProj {
    static constexpr bool PERM = true, AFTER_DRAIN = false;
    bf16_t* QKV; bf16_t* GATES;
    __device__ __forceinline__ void operator()(const f32x4 (&acc)[2][2][4][2], const Unit& u, int wr, int wc, int fr, int fq) const {
        const int row0 = u.pm * BM + wr * 64 + fr;
        const bool isg = u.pn >= 10;
        bf16_t* base = isg ? GATES : QKV; const int ldc = isg ? 3072 : 2560; const int colt = isg ? (u.pn - 10) * BM : u.pn * BM;
        const int col0 = colt + wc * 32 + 8 * fq;
#pragma unroll
        for (int ai = 0; ai < 2; ++ai)
#pragma unroll
            for (int m = 0; m < 4; ++m) { bf16_t* rowp = base + (size_t)(row0 + ai * HALF + m * 16) * ldc + col0;
#pragma unroll
                for (int bj = 0; bj < 2; ++bj) { f32x4 v0 = acc[ai][bj][m][0], v1 = acc[ai][bj][m][1];
                    u32x4 w; w.x = cvt_pk_bf16(v0[0], v0[1]); w.y = cvt_pk_bf16(v0[2], v0[3]); w.z = cvt_pk_bf16(v1[0], v1[1]); w.w = cvt_pk_bf16(v1[2], v1[3]);
                    __builtin_nontemporal_store(w, (u32x4*)(rowp + bj * HALF)); } }
    }
};
struct EpiPlain {
    static constexpr bool PERM = true, AFTER_DRAIN = false;
    bf16_t* O; int ldc;
    __device__ __forceinline__ void operator()(const f32x4 (&acc)[2][2][4][2], const Unit& u, int wr, int wc, int fr, int fq) const {
        const int row0 = u.pm * BM + wr * 64 + fr; const int col0 = u.pn * BM + wc * 32 + 8 * fq;
#pragma unroll
        for (int ai = 0; ai < 2; ++ai)
#pragma unroll
            for (int m = 0; m < 4; ++m) { bf16_t* rowp = O + (size_t)(row0 + ai * HALF + m * 16) * ldc + col0;
#pragma unroll
                for (int bj = 0; bj < 2; ++bj) { const f32x4 v0 = acc[ai][bj][m][0], v1 = acc[ai][bj][m][1];
                    u32x4 w; w.x = cvt_pk_bf16(v0[0], v0[1]); w.y = cvt_pk_bf16(v0[2], v0[3]); w.z = cvt_pk_bf16(v1[0], v1[1]); w.w = cvt_pk_bf16(v1[2], v1[3]);
                    *(u32x4*)(rowp + bj * HALF) = w; } }
    }
};
template <bool FIRST> struct EpiGate {
    static constexpr bool PERM = true, AFTER_DRAIN = false;
    bf16_t* MIX; const bf16_t* GATES; int goff;
    __device__ __forceinline__ void operator()(const f32x4 (&acc)[2][2][4][2], const Unit& u, int wr, int wc, int fr, int fq) const {
        const unsigned row0 = u.pm * BM + wr * 64 + fr; const unsigned col0 = u.pn * BM + wc * 32 + 8 * fq;
        const char* gb = (const char*)(GATES + goff); char* mb = (char*)MIX;
#pragma unroll
        for (int ai = 0; ai < 2; ++ai)
#pragma unroll
            for (int m = 0; m < 4; ++m) { const unsigned row = row0 + ai * HALF + m * 16;
#pragma unroll
                for (int bj = 0; bj < 2; ++bj) { const f32x4 v0 = acc[ai][bj][m][0], v1 = acc[ai][bj][m][1];
                    const unsigned goffb = (row * 3072u + col0 + bj * HALF) * 2u, moffb = (row * 1024u + col0 + bj * HALF) * 2u;
                    const u32x4 gt = *(const u32x4*)(gb + goffb);
                    float r[8];
                    r[0] = v0[0] * sigmoidf_(bf_lo(gt.x)); r[1] = v0[1] * sigmoidf_(bf_hi(gt.x)); r[2] = v0[2] * sigmoidf_(bf_lo(gt.y)); r[3] = v0[3] * sigmoidf_(bf_hi(gt.y));
                    r[4] = v1[0] * sigmoidf_(bf_lo(gt.z)); r[5] = v1[1] * sigmoidf_(bf_hi(gt.z)); r[6] = v1[2] * sigmoidf_(bf_lo(gt.w)); r[7] = v1[3] * sigmoidf_(bf_hi(gt.w));
                    if (!FIRST) { const u32x4 pv = *(const u32x4*)(mb + moffb);
                        r[0] += bf_lo(pv.x); r[1] += bf_hi(pv.x); r[2] += bf_lo(pv.y); r[3] += bf_hi(pv.y); r[4] += bf_lo(pv.z); r[5] += bf_hi(pv.z); r[6] += bf_lo(pv.w); r[7] += bf_hi(pv.w); }
                    u32x4 w; w.x = cvt_pk_bf16(r[0], r[1]); w.y = cvt_pk_bf16(r[2], r[3]); w.z = cvt_pk_bf16(r[4], r[5]); w.w = cvt_pk_bf16(r[6], r[7]);
                    *(u32x4*)(mb + moffb) = w; }
                if (m == 3) asm volatile("" ::: "memory"); }
    }
};
struct EpiRes1 {
    static constexpr bool PERM = true, AFTER_DRAIN = false;
    const float* X; float* OUT; bf16_t* X1B; float* SS;
    __device__ __forceinline__ void operator()(const f32x4 (&acc)[2][2][4][2], const Unit& u, int wr, int wc, int fr, int fq) const {
        const int row0 = u.pm * BM + wr * 64 + fr; const int col0 = u.pn * BM + wc * 32 + 8 * fq;
#pragma unroll
        for (int ai = 0; ai < 2; ++ai) {
            f32x4 xr[4][2][2];
#pragma unroll
            for (int m = 0; m < 4; ++m)
#pragma unroll
                for (int bj = 0; bj < 2; ++bj) { const size_t off = (size_t)(row0 + ai * HALF + m * 16) * 1024 + col0 + bj * HALF;
                    xr[m][bj][0] = *(const f32x4*)(X + off); xr[m][bj][1] = *(const f32x4*)(X + off + 4); }
#pragma unroll
            for (int m = 0; m < 4; ++m) { const size_t row = (size_t)(row0 + ai * HALF + m * 16); float ss = 0.f;
#pragma unroll
                for (int bj = 0; bj < 2; ++bj) { const size_t off = row * 1024 + col0 + bj * HALF;
                    const f32x4 v0 = acc[ai][bj][m][0] + xr[m][bj][0], v1 = acc[ai][bj][m][1] + xr[m][bj][1];
                    __builtin_nontemporal_store(v0, (f32x4*)(OUT + off)); __builtin_nontemporal_store(v1, (f32x4*)(OUT + off + 4));
                    ss += (v0[0] * v0[0] + v0[1] * v0[1]) + (v0[2] * v0[2] + v0[3] * v0[3]) + (v1[0] * v1[0] + v1[1] * v1[1]) + (v1[2] * v1[2] + v1[3] * v1[3]);
                    u32x4 w; w.x = cvt_pk_bf16(v0[0], v0[1]); w.y = cvt_pk_bf16(v0[2], v0[3]); w.z = cvt_pk_bf16(v1[0], v1[1]); w.w = cvt_pk_bf16(v1[2], v1[3]);
                    __builtin_nontemporal_store(w, (u32x4*)(X1B + off)); }
                ss += __shfl_xor(ss, 16); ss += __shfl_xor(ss, 32);
                if (fq == 0) __hip_atomic_fetch_add(SS + row, ss, __ATOMIC_RELAXED, __HIP_MEMORY_SCOPE_AGENT); }
            asm volatile("" ::: "memory"); }
    }
};
struct EpiSwiGLU {
    static constexpr bool PERM = true, AFTER_DRAIN = false;
    bf16_t* HB; const float* SS;
    __device__ __forceinline__ void operator()(const f32x4 (&acc)[2][2][4][2], const Unit& u, int wr, int wc, int fr, int fq) const {
        const int row0 = u.pm * BM + wr * 64 + fr; const int col0 = u.pn * HALF + wc * 32 + 8 * fq;
#pragma unroll
        for (int ai = 0; ai < 2; ++ai)
#pragma unroll
            for (int m = 0; m < 4; ++m) { const size_t row = (size_t)(row0 + ai * HALF + m * 16);
                const float rstd = __builtin_amdgcn_rsqf(SS[row] * (1.0f / 1024.0f) + 1e-6f);
                float r[8];
#pragma unroll
                for (int n = 0; n < 2; ++n)
#pragma unroll
                    for (int e = 0; e < 4; ++e) { const float gt = acc[ai][0][m][n][e] * rstd, up = acc[ai][1][m][n][e] * rstd; r[4 * n + e] = gt * sigmoidf_(gt) * up; }
                u32x4 w; w.x = cvt_pk_bf16(r[0], r[1]); w.y = cvt_pk_bf16(r[2], r[3]); w.z = cvt_pk_bf16(r[4], r[5]); w.w = cvt_pk_bf16(r[6], r[7]);
                __builtin_nontemporal_store(w, (u32x4*)(HB + row * 2816 + col0)); }
    }
};
struct EpiRes2 {
    static constexpr bool PERM = true, AFTER_DRAIN = false;
    float* OUT; const float* SRC;
    __device__ __forceinline__ void operator()(const f32x4 (&acc)[2][2][4][2], const Unit& u, int wr, int wc, int fr, int fq) const {
        const int row0 = u.pm * BM + wr * 64 + fr; const int col0 = u.pn * BM + wc * 32 + 8 * fq;
#pragma unroll
        for (int ai = 0; ai < 2; ++ai) {
            f32x4 xr[4][2][2];
#pragma unroll
            for (int m = 0; m < 4; ++m)
#pragma unroll
                for (int bj = 0; bj < 2; ++bj) { const size_t off = (size_t)(row0 + ai * HALF + m * 16) * 1024 + col0 + bj * HALF;
                    xr[m][bj][0] = *(const f32x4*)(SRC + off); xr[m][bj][1] = *(const f32x4*)(SRC + off + 4); }
#pragma unroll
            for (int m = 0; m < 4; ++m)
#pragma unroll
                for (int bj = 0; bj < 2; ++bj) { const size_t off = (size_t)(row0 + ai * HALF + m * 16) * 1024 + col0 + bj * HALF;
                    __builtin_nontemporal_store(acc[ai][bj][m][0] + xr[m][bj][0], (f32x4*)(OUT + off)); __builtin_nontemporal_store(acc[ai][bj][m][1] + xr[m][bj][1], (f32x4*)(OUT + off + 4)); }
            asm volatile("" ::: "memory"); }
    }
};
template <class Epi, class Sched, bool ALIGN_EPI = false, bool SP2 = false>
__device__ __forceinline__ void gemm_phase(PG8_LAS unsigned char* lds, const Gemm g, const Sched& S, const Epi& E) {
    const int tid = threadIdx.x, wid = __builtin_amdgcn_readfirstlane(tid >> 6), lane = tid & 63, wr = wid >> 2, wc = wid & 3, fr = lane & 15, fq = lane >> 4;
    const int K = g.K, nt = K / BK;
    unsigned voffA[2], voffB[2];
#pragma unroll
    for (int i = 0; i < 2; ++i) { int R, C; stage_rc(tid * 16 + i * 8192, R, C); const int Rb = Epi::PERM ? ((R & ~31) + perm32(R & 31)) : R;
        voffA[i] = (unsigned)(R * g.lda + C) * 2u; voffB[i] = (unsigned)(Rb * K + C) * 2u; }
    const size_t kstep = (size_t)(BK * 2);
    const size_t hstep = (size_t)HALF * K * 2, hstepA = (size_t)HALF * g.lda * 2;
    const size_t tstep = 2 * hstep, tstepA = 2 * hstepA;
    const unsigned ldsw = (unsigned)wid * 1024u;
    const int aoff = lds_byte(wr * 64 + fr, fq * 8), boff = lds_byte(wc * 32 + fr, fq * 8);
#define PG8_SA(b, h) (((b) * 2 + (h)) * HTB)
#define PG8_SB(b, h) ((4 + (b) * 2 + (h)) * HTB)
#define PG8_STAGE(bufoff, gbase, voff) do { _Pragma("unroll") for (int _i = 0; _i < 2; ++_i) \
        __builtin_amdgcn_global_load_lds((const unsigned*)((const char*)(gbase) + (voff)[_i]), (PG8_LAS unsigned*)(lds + (bufoff) + ldsw + _i * 8192), 16, 0, 0); } while (0)
#define PG8_LDA(dst, b, h) do { _Pragma("unroll") for (int m = 0; m < 4; ++m) _Pragma("unroll") for (int k = 0; k < 2; ++k) dst[m][k] = *(const PG8_LAS bf16x8*)(lds + PG8_SA(b, h) + aoff + m * 2048 + k * 1024); } while (0)
#define PG8_LDB(dst, b, h) do { _Pragma("unroll") for (int n = 0; n < 2; ++n) _Pragma("unroll") for (int k = 0; k < 2; ++k) dst[n][k] = *(const PG8_LAS bf16x8*)(lds + PG8_SB(b, h) + boff + n * 2048 + k * 1024); } while (0)
#define PG8_MMA(ai, bj, At, Bt) do { __builtin_amdgcn_s_setprio(1); _Pragma("unroll") for (int m = 0; m < 4; ++m) _Pragma("unroll") for (int n = 0; n < 2; ++n) _Pragma("unroll") for (int k = 0; k < 2; ++k) \
        acc[ai][bj][m][n] = __builtin_amdgcn_mfma_f32_16x16x32_bf16(Bt[n][k], At[m][k], acc[ai][bj][m][n], 0, 0, 0); __builtin_amdgcn_s_setprio(0); } while (0)
#define PG8_WAIT_V(n) asm volatile("s_waitcnt vmcnt(" #n ")" ::: "memory")
#define PG8_WAIT_L(n) asm volatile("s_waitcnt lgkmcnt(" #n ")" ::: "memory")
#define PG8_BAR __builtin_amdgcn_s_barrier()
#define PG8_SCHED __builtin_amdgcn_sched_barrier(0)
    Unit cur, nxt; int ui = 0;
    if (!S.next(0, cur)) return;
    f32x4 acc[2][2][4][2];
#pragma unroll
    for (int a = 0; a < 2; ++a)
#pragma unroll
        for (int b = 0; b < 2; ++b)
#pragma unroll
            for (int m = 0; m < 4; ++m)
#pragma unroll
                for (int n = 0; n < 2; ++n) acc[a][b][m][n] = (f32x4){0.f, 0.f, 0.f, 0.f};
    bf16x8 At[4][2], B0[2][2], B1[2][2];
    const char* cA = (const char*)g.A + (size_t)cur.pm * tstepA; const char* cB = (const char*)g.Bt + (size_t)cur.pn * tstep;
    S.a_ready(cur);
    if constexpr (SP2) {
        PG8_STAGE(PG8_SB(0, 0), cB, voffB); PG8_STAGE(PG8_SB(0, 1), cB + hstep, voffB); PG8_STAGE(PG8_SA(0, 0), cA, voffA); PG8_STAGE(PG8_SA(0, 1), cA + hstepA, voffA);
        if (wr == 1) PG8_BAR;
        PG8_WAIT_V(2); PG8_BAR;
        PG8_STAGE(PG8_SB(1, 0), cB + kstep, voffB); PG8_STAGE(PG8_SA(1, 0), cA + kstep, voffA); PG8_STAGE(PG8_SB(1, 1), cB + hstep + kstep, voffB);
        PG8_WAIT_V(6); PG8_BAR;
    } else {
        PG8_STAGE(PG8_SB(0, 0), cB, voffB); PG8_STAGE(PG8_SA(0, 0), cA, voffA); PG8_STAGE(PG8_SB(0, 1), cB + hstep, voffB); PG8_STAGE(PG8_SA(0, 1), cA + hstepA, voffA);
        if (wr == 1) PG8_BAR;
        PG8_WAIT_V(4); PG8_BAR;
        PG8_STAGE(PG8_SB(1, 0), cB + kstep, voffB); PG8_STAGE(PG8_SA(1, 0), cA + kstep, voffA); PG8_STAGE(PG8_SB(1, 1), cB + hstep + kstep, voffB);
        PG8_WAIT_V(6); PG8_BAR;
    }
    for (;;) {
        const bool has_next = S.next(ui + 1, nxt);
        const char* nA = has_next ? (const char*)g.A + (size_t)nxt.pm * tstepA : cA; const char* nB = has_next ? (const char*)g.Bt + (size_t)nxt.pn * tstep : cB;
#pragma nounroll
        for (int t = 0; t < nt; t += 2) {
            const bool last = (t == nt - 2);
            const char* a1 = cA + (size_t)(t + 1) * kstep;
            const char* a2 = last ? nA : cA + (size_t)(t + 2) * kstep; const char* b2 = last ? nB : cB + (size_t)(t + 2) * kstep;
            const char* a3 = a2 + kstep; const char* b3 = b2 + kstep;
            if (last && has_next) S.a_ready(nxt);
            if constexpr (SP2) {
            PG8_LDB(B0, 0, 0); PG8_LDB(B1, 0, 1); PG8_SCHED; PG8_LDA(At, 0, 0); PG8_STAGE(PG8_SA(1, 1), a1 + hstepA, voffA);
            PG8_WAIT_V(8); PG8_WAIT_L(0); PG8_BAR; PG8_MMA(0, 0, At, B0); PG8_MMA(0, 1, At, B1); PG8_BAR; PG8_SCHED;
            PG8_LDA(At, 0, 1); PG8_STAGE(PG8_SB(0, 0), b2, voffB); PG8_STAGE(PG8_SB(0, 1), b2 + hstep, voffB); PG8_STAGE(PG8_SA(0, 0), a2, voffA);
            PG8_WAIT_V(8); PG8_WAIT_L(0); PG8_BAR; PG8_MMA(1, 0, At, B0); PG8_MMA(1, 1, At, B1); PG8_BAR; PG8_SCHED;
            PG8_LDB(B0, 1, 0); PG8_LDB(B1, 1, 1); PG8_SCHED; PG8_LDA(At, 1, 0); PG8_STAGE(PG8_SA(0, 1), a2 + hstepA, voffA);
            PG8_WAIT_V(8); PG8_WAIT_L(0); PG8_BAR; PG8_MMA(0, 0, At, B0); PG8_MMA(0, 1, At, B1); PG8_BAR; PG8_SCHED;
            PG8_LDA(At, 1, 1); PG8_STAGE(PG8_SB(1, 0), b3, voffB); PG8_STAGE(PG8_SB(1, 1), b3 + hstep, voffB); PG8_STAGE(PG8_SA(1, 0), a3, voffA);
            PG8_WAIT_V(8); PG8_WAIT_L(0); PG8_BAR; PG8_MMA(1, 0, At, B0); PG8_MMA(1, 1, At, B1); PG8_BAR; PG8_SCHED;
            } else {
            PG8_LDB(B0, 0, 0); PG8_SCHED; PG8_LDA(At, 0, 0); PG8_STAGE(PG8_SA(1, 1), a1 + hstepA, voffA);
            PG8_WAIT_L(8); PG8_BAR; PG8_WAIT_L(0); PG8_MMA(0, 0, At, B0); PG8_BAR; PG8_SCHED;
            PG8_LDB(B1, 0, 1); PG8_STAGE(PG8_SB(0, 0), b2, voffB);
            PG8_BAR; PG8_WAIT_L(0); PG8_MMA(0, 1, At, B1); PG8_BAR;
            PG8_LDA(At, 0, 1); PG8_STAGE(PG8_SA(0, 0), a2, voffA);
            PG8_BAR; PG8_WAIT_L(0); PG8_MMA(1, 0, At, B0); PG8_BAR; PG8_SCHED;
            PG8_STAGE(PG8_SB(0, 1), b2 + hstep, voffB);
            PG8_WAIT_V(6); PG8_BAR; PG8_MMA(1, 1, At, B1); PG8_BAR;
            PG8_LDB(B0, 1, 0); PG8_SCHED; PG8_LDA(At, 1, 0); PG8_STAGE(PG8_SA(0, 1), a2 + hstepA, voffA);
            PG8_WAIT_L(8); PG8_BAR; PG8_WAIT_L(0); PG8_MMA(0, 0, At, B0); PG8_BAR; PG8_SCHED;
            PG8_LDB(B1, 1, 1); PG8_STAGE(PG8_SB(1, 0), b3, voffB);
            PG8_BAR; PG8_WAIT_L(0); PG8_MMA(0, 1, At, B1); PG8_BAR;
            PG8_LDA(At, 1, 1); PG8_STAGE(PG8_SA(1, 0), a3, voffA);
            PG8_BAR; PG8_WAIT_L(0); PG8_MMA(1, 0, At, B0); PG8_BAR; PG8_SCHED;
            PG8_STAGE(PG8_SB(1, 1), b3 + hstep, voffB);
            PG8_WAIT_V(6); PG8_BAR; PG8_MMA(1, 1, At, B1); PG8_BAR;
            }
        }
        if constexpr (ALIGN_EPI) { if (wr == 0) PG8_BAR; }
        if constexpr (!Epi::AFTER_DRAIN) { E(acc, cur, wr, wc, fr, fq); S.done(cur); }
        if (!has_next) break;
#pragma unroll
        for (int a = 0; a < 2; ++a)
#pragma unroll
            for (int b = 0; b < 2; ++b)
#pragma unroll
                for (int m = 0; m < 4; ++m)
#pragma unroll
                    for (int n = 0; n < 2; ++n) acc[a][b][m][n] = (f32x4){0.f, 0.f, 0.f, 0.f};
        cur = nxt; cA = nA; cB = nB; ++ui;
        if constexpr (ALIGN_EPI) { if (wr == 1) PG8_BAR; }
    }
    PG8_WAIT_V(0);
    if constexpr (!ALIGN_EPI) { if (wr == 0) PG8_BAR; }
    PG8_BAR;
    if constexpr (Epi::AFTER_DRAIN) { E.fused(acc, cur, wr, wc, fr, fq, lds, wid, lane); S.done(cur); }
#undef PG8_SA
#undef PG8_SB
#undef PG8_STAGE
#undef PG8_LDA
#undef PG8_LDB
#undef PG8_MMA
#undef PG8_WAIT_V
#undef PG8_WAIT_L
#undef PG8_BAR
#undef PG8_SCHED
}
}

#define LAS __attribute__((address_space(3)))
typedef unsigned short bf16_t;
typedef short bf16x8 __attribute__((ext_vector_type(8)));
typedef float f32x4 __attribute__((ext_vector_type(4)));
typedef unsigned u32x4 __attribute__((ext_vector_type(4)));
typedef unsigned u32x2 __attribute__((ext_vector_type(2)));
using pg8::cvt_pk_bf16; using pg8::bf_lo; using pg8::bf_hi;

constexpr int NB = 4, S = 8192, DM = 1024, M = NB * S, INW = 5632, DFF = 2816, MEML = 256;
constexpr int QKVW = 2560, GW = 3072;
constexpr int C_SBQ = 0, C_SBK = 384, C_SBV = 768, C_MOQ = 1152, C_MOK = 1536, C_MOV = 1920, C_MEQ = 2304;
constexpr float EPS = 1e-6f;
constexpr float LOG2E = 1.4426950408889634f;
constexpr float SC2 = LOG2E * 0.125f;

constexpr size_t MiB = (size_t)1 << 20;
constexpr size_t WS_CTL = 0;
constexpr size_t WS_BAR = 16 * 1024;
constexpr size_t WS_SS = 64 * 1024;
constexpr size_t WS_KMEAN = 256 * 1024;
constexpr size_t WS_MEMN = 1 * MiB;
constexpr size_t WS_MEMKV = 3 * MiB;
constexpr size_t WS_MEMVT = 4 * MiB;
constexpr size_t WS_WMEMKV = 5 * MiB;
constexpr size_t WS_WIN = 6 * MiB;
constexpr size_t WS_WFIN = 17 * MiB;
constexpr size_t WS_WFDN = 28 * MiB;
constexpr size_t WS_WOUT = 34 * MiB;
constexpr size_t WS_WUPSB = 36 * MiB, WS_WUPMO = 37 * MiB, WS_WUPME = 38 * MiB;
constexpr size_t WS_SEL = 39 * MiB;
constexpr size_t WS_XN = 40 * MiB;
constexpr size_t WS_SBVT = 104 * MiB, WS_MOVT = 128 * MiB;
constexpr size_t WS_QKV = 152 * MiB;
constexpr size_t WS_GATES = 312 * MiB;
constexpr size_t WS_ROPE = 504 * MiB;
constexpr size_t WS_END = 506 * MiB;
constexpr int LDS_BYTES = 156 * 1024;

#ifndef PHMASK
#define PHMASK 255
#endif
#ifndef WGM_WIDE
#define WGM_WIDE 4
#endif
#ifndef WGM_P3
#define WGM_P3 8
#endif
#ifndef WGM_P4
#define WGM_P4 8
#endif
#ifndef WGM_P6
#define WGM_P6 8
#endif
struct Params { const float* in[17]; float* out; unsigned char* ws; };

__device__ __forceinline__ float wave_sum(float v) {
#pragma unroll
    for (int o = 1; o < 64; o <<= 1) v += __shfl_xor(v, o);
    return v;
}
#define LDS_WAIT() asm volatile("s_waitcnt lgkmcnt(0)" ::: "memory")
#define BAR_LDS() do { asm volatile("s_waitcnt lgkmcnt(0)" ::: "memory"); __builtin_amdgcn_s_barrier(); asm volatile("" ::: "memory"); } while (0)

template <int MODE>
__device__ __forceinline__ void p0_transpose_item(const float* W, int K, int N, bf16_t* WT, LAS float* scr, int item, int lane, const float* kscale) {
    const int nblk = N / 32, kb = item / nblk, nb = item % nblk, k0 = 64 * kb, n0 = 32 * nb;
#pragma unroll 8
    for (int i = 0; i < 32; ++i) { const int kk = 2 * i + (lane >> 5); float v = W[(size_t)(k0 + kk) * N + n0 + (lane & 31)]; if (MODE == 1) v *= kscale[k0 + kk]; scr[kk * 33 + (lane & 31)] = v; }
    LDS_WAIT();
    int r0 = n0;
    if (MODE == 1) { if (n0 < DFF) r0 = (n0 >> 7) * 256 + (n0 & 127); else { const int n2 = n0 - DFF; r0 = (n2 >> 7) * 256 + 128 + (n2 & 127); } }
    const int c = lane & 7;
#pragma unroll
    for (int j = 0; j < 4; ++j) { const int n = (lane >> 3) + 8 * j; const LAS float* s = scr + (8 * c) * 33 + n;
        u32x4 o; o.x = cvt_pk_bf16(s[0 * 33], s[1 * 33]); o.y = cvt_pk_bf16(s[2 * 33], s[3 * 33]); o.z = cvt_pk_bf16(s[4 * 33], s[5 * 33]); o.w = cvt_pk_bf16(s[6 * 33], s[7 * 33]);
        *(u32x4*)(WT + (size_t)(r0 + n) * K + k0 + 8 * c) = o; }
    LDS_WAIT();
}
__device__ __forceinline__ void rms_row_to_bf16(const float* xrow, const float* gain, bf16_t* orow, int lane) {
    const f32x4* xr = (const f32x4*)xrow + lane; const f32x4* gr = (const f32x4*)gain + lane;
    f32x4 v[4]; float s = 0.f;
#pragma unroll
    for (int j = 0; j < 4; ++j) { v[j] = xr[64 * j]; s += (v[j].x * v[j].x + v[j].y * v[j].y) + (v[j].z * v[j].z + v[j].w * v[j].w); }
    const float rstd = __builtin_amdgcn_rsqf(wave_sum(s) * (1.f / 1024.f) + EPS);
    u32x2* o8 = (u32x2*)orow + lane;
#pragma unroll
    for (int j = 0; j < 4; ++j) { const f32x4 g = gr[64 * j]; u32x2 w; w.x = cvt_pk_bf16(v[j].x * rstd * g.x, v[j].y * rstd * g.y); w.y = cvt_pk_bf16(v[j].z * rstd * g.z, v[j].w * rstd * g.w); o8[64 * j] = w; }
}
__device__ __forceinline__ void rope_entry(int idx, float2* tab) {
    const double INVF[32] = {1.0, 0.7498942093324559, 0.5623413251903491, 0.4216965034285822, 0.31622776601683794, 0.23713737056616552, 0.1778279410038923, 0.1333521432163324, 0.1, 0.07498942093324558, 0.05623413251903491, 0.042169650342858224, 0.03162277660168379, 0.023713737056616554, 0.01778279410038923, 0.01333521432163324, 0.01, 0.007498942093324558, 0.005623413251903491, 0.004216965034285823, 0.0031622776601683794, 0.0023713737056616554, 0.0017782794100389228, 0.001333521432163324, 0.001, 0.0007498942093324559, 0.0005623413251903491, 0.00042169650342858224, 0.00031622776601683794, 0.00023713737056616554, 0.00017782794100389227, 0.0001333521432163324};
    const int pos = idx >> 5, f = idx & 31;
    double invf = 1.0;
#pragma unroll
    for (int i = 0; i < 32; ++i) invf = (f == i) ? INVF[i] : invf;
    const double ang = (double)pos * invf;
    const double k = __builtin_rint(ang * 0.15915494309189535);
    const double r = __builtin_fma(-k, 6.283185307179586, ang);
    const double h = r * 0.25, h2 = h * h;
    double sn = 1.0 / 6227020800.0; sn = sn * h2 - 1.0 / 39916800.0; sn = sn * h2 + 1.0 / 362880.0; sn = sn * h2 - 1.0 / 5040.0; sn = sn * h2 + 1.0 / 120.0; sn = sn * h2 - 1.0 / 6.0; sn = sn * h2 + 1.0; sn *= h;
    double cs = -1.0 / 87178291200.0; cs = cs * h2 + 1.0 / 479001600.0; cs = cs * h2 - 1.0 / 3628800.0; cs = cs * h2 + 1.0 / 40320.0; cs = cs * h2 - 1.0 / 720.0; cs = cs * h2 + 1.0 / 24.0; cs = cs * h2 - 0.5; cs = cs * h2 + 1.0;
    const double s2 = 2.0 * sn * cs, c2 = 1.0 - 2.0 * sn * sn;
    const double s4 = 2.0 * s2 * c2, c4 = 1.0 - 2.0 * s2 * s2;
    tab[idx] = make_float2((float)c4, (float)s4);
}

__device__ __forceinline__ void head_norm_item(bf16_t* base, int ld, const float* gain, const float2* rope_tab, float* kmean_out, LAS float* red, int tid) {
    const int sub = tid & 7, rl = tid >> 3, lane = tid & 63, wave = tid >> 6;
    float gv[8], accm[8];
#pragma unroll
    for (int i = 0; i < 8; ++i) { gv[i] = gain ? gain[sub * 8 + i] : 1.0f; accm[i] = 0.f; }
    u32x4 raw4[4];
#pragma unroll
    for (int pass = 0; pass < 4; ++pass) raw4[pass] = *(const u32x4*)(base + (size_t)(pass * 64 + rl) * ld + sub * 8);
#pragma unroll
    for (int pass = 0; pass < 4; ++pass) {
        const int row = pass * 64 + rl;
        bf16_t* ptr = base + (size_t)row * ld + sub * 8;
        const u32x4 raw = raw4[pass];
        float v[8] = {bf_lo(raw.x), bf_hi(raw.x), bf_lo(raw.y), bf_hi(raw.y), bf_lo(raw.z), bf_hi(raw.z), bf_lo(raw.w), bf_hi(raw.w)};
        float ss = 0.f;
#pragma unroll
        for (int i = 0; i < 8; ++i) ss += v[i] * v[i];
        ss += __shfl_xor(ss, 1); ss += __shfl_xor(ss, 2); ss += __shfl_xor(ss, 4);
        const float r = __builtin_amdgcn_rsqf(ss * (1.f / 64.f) + EPS);
#pragma unroll
        for (int i = 0; i < 8; ++i) v[i] = v[i] * r * gv[i];
        if (rope_tab) {
            const f32x4* t = (const f32x4*)(rope_tab + (size_t)row * 32 + (sub & 3) * 8);
#pragma unroll
            for (int i = 0; i < 4; ++i) { const f32x4 cs = t[i];
                const float p0 = __shfl_xor(v[2 * i], 4), p1 = __shfl_xor(v[2 * i + 1], 4);
                v[2 * i] = (sub < 4) ? (v[2 * i] * cs[0] - p0 * cs[1]) : (v[2 * i] * cs[0] + p0 * cs[1]);
                v[2 * i + 1] = (sub < 4) ? (v[2 * i + 1] * cs[2] - p1 * cs[3]) : (v[2 * i + 1] * cs[2] + p1 * cs[3]); }
        }
        u32x4 w; w.x = cvt_pk_bf16(v[0], v[1]); w.y = cvt_pk_bf16(v[2], v[3]); w.z = cvt_pk_bf16(v[4], v[5]); w.w = cvt_pk_bf16(v[6], v[7]);
        *(u32x4*)ptr = w;
#pragma unroll
        for (int i = 0; i < 8; ++i) accm[i] += v[i];
    }
    if (kmean_out) {
#pragma unroll
        for (int i = 0; i < 8; ++i) { accm[i] += __shfl_xor(accm[i], 8); accm[i] += __shfl_xor(accm[i], 16); accm[i] += __shfl_xor(accm[i], 32); }
        if (lane < 8) {
#pragma unroll
            for (int i = 0; i < 8; ++i) red[wave * 64 + sub * 8 + i] = accm[i]; }
        __syncthreads();
        if (tid < 64) { float s = 0.f;
#pragma unroll
            for (int w = 0; w < 8; ++w) s += red[w * 64 + tid];
            kmean_out[tid] = s * (1.f / 256.f); }
        __syncthreads();
    }
}
__device__ __forceinline__ void transpose_item256(const bf16_t* src, int ld, bf16_t* dst, size_t dpitch, LAS unsigned short* tile, int tid) {
#pragma unroll
    for (int pass = 0; pass < 4; ++pass) { const int row = pass * 64 + (tid >> 3), sub = tid & 7;
        const u32x4 raw = *(const u32x4*)(src + (size_t)row * ld + sub * 8);
        LAS unsigned* t32 = (LAS unsigned*)(tile + row * 66 + sub * 8); t32[0] = raw.x; t32[1] = raw.y; t32[2] = raw.z; t32[3] = raw.w; }
    __syncthreads();
    const int d = tid & 63, chunk = tid >> 6;
#pragma unroll
    for (int c4 = 0; c4 < 4; ++c4) { const int t0 = chunk * 32 + c4 * 8; unsigned w[4];
#pragma unroll
        for (int i = 0; i < 4; ++i) { const unsigned lo = tile[(t0 + 2 * i) * 66 + d], hi = tile[(t0 + 2 * i + 1) * 66 + d]; w[i] = lo | (hi << 16); }
        u32x4 o; o.x = w[0]; o.y = w[1]; o.z = w[2]; o.w = w[3];
        *(u32x4*)(dst + (size_t)d * dpitch + t0) = o; }
    __syncthreads();
}

__device__ __forceinline__ f32x4 mfma16(bf16x8 a, bf16x8 b, f32x4 c) { return __builtin_amdgcn_mfma_f32_16x16x32_bf16(a, b, c, 0, 0, 0); }
constexpr int KPB = 160;
template <int NK> __device__ __forceinline__ void stage_k(LAS unsigned char* Kt, const bf16_t* src, int ld, int tid) {
#pragma unroll
    for (int i = 0; i < NK / 64; ++i) { const int row = i * 64 + (tid >> 3), ch = tid & 7;
        const u32x4 v = *(const u32x4*)(src + (size_t)row * ld + ch * 8);
        *(LAS u32x4*)(Kt + row * KPB + ch * 16) = v; }
}
template <int NK> __device__ __forceinline__ void stage_vt(LAS unsigned char* Vt, const bf16_t* src, size_t gp, int tid) {
    constexpr int CPR = NK / 8, RPP = 512 / CPR, VPB = NK * 2 + 16;
#pragma unroll
    for (int i = 0; i < 64 / RPP; ++i) { const int d = i * RPP + tid / CPR, ch = tid % CPR;
        const u32x4 v = *(const u32x4*)(src + (size_t)d * gp + ch * 8);
        *(LAS u32x4*)(Vt + d * VPB + ch * 16) = v; }
}
template <int NK> struct StageRegs { u32x4 k[NK / 64]; u32x4 v[NK / 64]; };
template <int NK> __device__ __forceinline__ void stage_load(StageRegs<NK>& r, const bf16_t* ksrc, int ld, const bf16_t* vsrc, size_t gp, int tid) {
    constexpr int CPR = NK / 8, RPP = 512 / CPR;
#pragma unroll
    for (int i = 0; i < NK / 64; ++i) { const int row = i * 64 + (tid >> 3), ch = tid & 7; r.k[i] = *(const u32x4*)(ksrc + (size_t)row * ld + ch * 8); }
#pragma unroll
    for (int i = 0; i < 64 / RPP; ++i) { const int d = i * RPP + tid / CPR, ch = tid % CPR; r.v[i] = *(const u32x4*)(vsrc + (size_t)d * gp + ch * 8); }
}
template <int NK> __device__ __forceinline__ void stage_store(const StageRegs<NK>& r, LAS unsigned char* Kt, LAS unsigned char* Vt, int tid) {
    constexpr int CPR = NK / 8, RPP = 512 / CPR, VPB = NK * 2 + 16;
#pragma unroll
    for (int i = 0; i < NK / 64; ++i) { const int row = i * 64 + (tid >> 3), ch = tid & 7; *(LAS u32x4*)(Kt + row * KPB + ch * 16) = r.k[i]; }
#pragma unroll
    for (int i = 0; i < 64 / RPP; ++i) { const int d = i * RPP + tid / CPR, ch = tid % CPR; *(LAS u32x4*)(Vt + d * VPB + ch * 16) = r.v[i]; }
}
__device__ __forceinline__ bf16x8 kfrag(const LAS unsigned char* Kt, int kt, int ks, int lr, int g) { return *(const LAS bf16x8*)(Kt + (kt * 16 + lr) * KPB + ks * 64 + g * 16); }
template <int VPB> __device__ __forceinline__ bf16x8 vfrag(const LAS unsigned char* Vt, int dt, int keybase, int lr, int g) {
    const LAS unsigned char* p = Vt + (16 * dt + lr) * VPB + (keybase + 4 * g) * 2;
    const u32x2 lo = *(const LAS u32x2*)p, hi = *(const LAS u32x2*)(p + 32);
    u32x4 w; w.x = lo.x; w.y = lo.y; w.z = hi.x; w.w = hi.y; return __builtin_bit_cast(bf16x8, w);
}
__device__ __forceinline__ bf16x8 pack_p(const f32x4 a, const f32x4 b) { u32x4 w; w.x = cvt_pk_bf16(a[0], a[1]); w.y = cvt_pk_bf16(a[2], a[3]); w.z = cvt_pk_bf16(b[0], b[1]); w.w = cvt_pk_bf16(b[2], b[3]); return __builtin_bit_cast(bf16x8, w); }
__device__ __forceinline__ void store_o16(LAS unsigned char* scr, const f32x4 (&o)[4], bf16_t* gbase, int lane) {
    const int lr = lane & 15, g = lane >> 4;
#pragma unroll
    for (int dt = 0; dt < 4; ++dt)
#pragma unroll
        for (int j = 0; j < 4; ++j) *(LAS unsigned short*)(scr + (4 * g + j) * 144 + (16 * dt + lr) * 2) = (unsigned short)(cvt_pk_bf16(o[dt][j], 0.f) & 0xffffu);
    LDS_WAIT();
#pragma unroll
    for (int c = 0; c < 2; ++c) { const int idx = lane + 64 * c, row = idx >> 3, ch = idx & 7;
        const u32x4 v = *(const LAS u32x4*)(scr + row * 144 + ch * 16);
        *(u32x4*)(gbase + (size_t)row * DM + ch * 8) = v; }
    LDS_WAIT();
}
__device__ __forceinline__ void load_qfrag(bf16x8 (&qf)[2], const bf16_t* qrow, int g) { qf[0] = *(const bf16x8*)(qrow + g * 8); qf[1] = *(const bf16x8*)(qrow + 32 + g * 8); }

__device__ __forceinline__ void sb_unit(LAS unsigned char* lds, const bf16_t* QKV, const bf16_t* SBVT, bf16_t* O, int b, int h, int qt, int tid) {
    constexpr int VPB = 128 * 2 + 16;
    LAS unsigned char* Kt = lds; LAS unsigned char* Vt = lds + 128 * KPB;
    const int lane = tid & 63, w = tid >> 6, lr = lane & 15, g = lane >> 4;
    const int t0 = qt * 128; const size_t rowbase = (size_t)b * S;
    bf16x8 qf[2]; load_qfrag(qf, QKV + (rowbase + t0 + 16 * w + lr) * QKVW + C_SBQ + h * 64, g);
    f32x4 o[4];
#pragma unroll
    for (int dt = 0; dt < 4; ++dt) o[dt] = (f32x4){0.f, 0.f, 0.f, 0.f};
    float R = 1.f; bool wdone = false;
    LAS int* dflag = (LAS int*)(lds + 59392);
    int itp = 0;
    const int tl = 16 * w + lr;
    const bf16_t* ksb = QKV + rowbase * QKVW + C_SBK + h * 64; const bf16_t* vsb = SBVT + ((size_t)(b * 6 + h) * 64) * S;
    StageRegs<128> sr; stage_load<128>(sr, ksb + (size_t)qt * 128 * QKVW, QKVW, vsb + (size_t)qt * 128, S, tid);
    for (int kb = qt; kb >= 0; --kb) {
        stage_store<128>(sr, Kt, Vt, tid);
        if (kb > 0) stage_load<128>(sr, ksb + (size_t)(kb - 1) * 128 * QKVW, QKVW, vsb + (size_t)(kb - 1) * 128, S, tid);
        BAR_LDS();
        if (!wdone) {
            const int lim = (kb == qt) ? tl : 4096;
            const int ktmax = (kb == qt) ? __builtin_amdgcn_readfirstlane(w) : 7;
            f32x4 p[8];
#pragma unroll
            for (int kt = 0; kt < 8; ++kt) { f32x4 s = (f32x4){0.f, 0.f, 0.f, 0.f};
                if (kt <= ktmax) { s = mfma16(kfrag(Kt, kt, 0, lr, g), qf[0], s); s = mfma16(kfrag(Kt, kt, 1, lr, g), qf[1], s); }
                p[kt] = s; if (kt & 1) asm volatile("" ::: "memory"); }
#pragma unroll
            for (int kt = 7; kt >= 0; --kt) {
                if (kt <= ktmax) {
                    float bt[4], om[4];
#pragma unroll
                    for (int j = 0; j < 4; ++j) { const float y = p[kt][j] * SC2; const float e = __builtin_amdgcn_exp2f(-fabsf(y)); const float r = __builtin_amdgcn_rcpf(1.0f + e); const float er = e * r;
                        const bool valid = (kt * 16 + 4 * g + j) < lim; const bool pos = y >= 0.f;
                        bt[j] = valid ? (pos ? r : er) : 0.f; om[j] = valid ? (pos ? er : r) : 1.f; }
                    const float suf2 = om[3], suf1 = om[3] * om[2], suf0 = suf1 * om[1], T = suf0 * om[0];
                    const float x1 = __shfl_xor(T, 16); const float a_ = T * x1; const float x2 = __shfl_xor(a_, 32); const float tot = a_ * x2;
                    const float above = (g == 0) ? (x1 * x2) : (g == 1) ? x2 : (g == 2) ? x1 : 1.f;
                    const float bs = R * above;
                    p[kt][0] = bt[0] * (bs * suf0); p[kt][1] = bt[1] * (bs * suf1); p[kt][2] = bt[2] * (bs * suf2); p[kt][3] = bt[3] * bs;
                    R *= tot;
                }
            }
#pragma unroll
            for (int i = 0; i < 4; ++i) { const bf16x8 a = pack_p(p[2 * i], p[2 * i + 1]);
#pragma unroll
                for (int dt = 0; dt < 4; ++dt) o[dt] = mfma16(a, vfrag<VPB>(Vt, dt, 32 * i, lr, g), o[dt]);
                asm volatile("" ::: "memory"); }
#ifndef SB_NOEXIT
            wdone = __all(R == 0.0f);
#endif
        }
        if (lane == 0) dflag[itp * 8 + w] = wdone ? 1 : 0;
        BAR_LDS();
        { const int f = dflag[itp * 8 + (lane & 7)]; itp ^= 1; if (__all(f != 0)) break; }
    }
    store_o16(lds + 40960 + w * 2304, o, O + (rowbase + t0 + 16 * w) * DM + h * 64, lane);
    __syncthreads();
}

__device__ __forceinline__ void softmax256(f32x4 (&s)[16], float& mx, float& sum) {
    float m = -INFINITY;
#pragma unroll
    for (int kt = 0; kt < 16; ++kt) m = fmaxf(m, fmaxf(fmaxf(s[kt][0], s[kt][1]), fmaxf(s[kt][2], s[kt][3])));
    m = fmaxf(m, __shfl_xor(m, 16)); m = fmaxf(m, __shfl_xor(m, 32));
    const float ms = m * SC2; float l = 0.f;
#pragma unroll
    for (int kt = 0; kt < 16; ++kt)
#pragma unroll
        for (int j = 0; j < 4; ++j) { const float e = __builtin_amdgcn_exp2f(s[kt][j] * SC2 - ms); s[kt][j] = e; l += e; }
    l += __shfl_xor(l, 16); l += __shfl_xor(l, 32);
    mx = ms; sum = l;
}

__device__ __forceinline__ void moba_select_unit(LAS unsigned char* lds, const bf16_t* QKV, const float* KMEAN, unsigned* SEL, int b, int h, int jb, int tid) {
    LAS float* kmb = (LAS float*)lds;
    { const float* src = KMEAN + (size_t)((b * 6 + h) * 32) * 64; for (int i = tid; i < jb * 64; i += 512) kmb[i] = src[i]; }
    __syncthreads();
    {
        const int q = tid >> 1, hf = tid & 1;
        float qv[32];
        const bf16_t* qr = QKV + ((size_t)b * S + (size_t)jb * 256 + q) * QKVW + C_MOQ + h * 64 + hf * 32;
#pragma unroll
        for (int c = 0; c < 4; ++c) { const u32x4 raw = *(const u32x4*)(qr + c * 8); qv[c * 8 + 0] = bf_lo(raw.x); qv[c * 8 + 1] = bf_hi(raw.x); qv[c * 8 + 2] = bf_lo(raw.y); qv[c * 8 + 3] = bf_hi(raw.y);
            qv[c * 8 + 4] = bf_lo(raw.z); qv[c * 8 + 5] = bf_hi(raw.z); qv[c * 8 + 6] = bf_lo(raw.w); qv[c * 8 + 7] = bf_hi(raw.w); }
        float v1 = -INFINITY, v2 = -INFINITY, v3 = -INFINITY; unsigned i1 = 255u, i2 = 255u, i3 = 255u;
        const LAS float* km = kmb + hf * 32;
        for (int n = 0; n < jb; ++n) {
            float d0 = 0.f, d1 = 0.f, d2 = 0.f, d3 = 0.f;
#pragma unroll
            for (int c = 0; c < 8; ++c) { const f32x4 kv = *(const LAS f32x4*)(km + n * 64 + c * 4); d0 += qv[c * 4] * kv[0]; d1 += qv[c * 4 + 1] * kv[1]; d2 += qv[c * 4 + 2] * kv[2]; d3 += qv[c * 4 + 3] * kv[3]; }
            float gt = (d0 + d1) + (d2 + d3);
            gt += __shfl_xor(gt, 1);
            if (gt > v1) { v3 = v2; i3 = i2; v2 = v1; i2 = i1; v1 = gt; i1 = (unsigned)n; }
            else if (gt > v2) { v3 = v2; i3 = i2; v2 = gt; i2 = (unsigned)n; }
            else if (gt > v3) { v3 = gt; i3 = (unsigned)n; }
        }
        if (hf == 0) SEL[(size_t)(b * 6 + h) * S + (size_t)jb * 256 + q] = i1 | (i2 << 8) | (i3 << 16);
    }
    __syncthreads();
}

template <bool MASKED, int VPB>
__device__ __forceinline__ void kv_tile(const LAS unsigned char* Kt, const LAS unsigned char* Vt, const bf16x8 (&qf)[2], int qlim, float mx, int lr, int g, float& sum_out, f32x4 (&o)[4]) {
    float sum = 0.f;
#pragma unroll
    for (int dt = 0; dt < 4; ++dt) o[dt] = (f32x4){0.f, 0.f, 0.f, 0.f};
#pragma unroll
    for (int hf = 0; hf < 2; ++hf) {
        f32x4 s[8];
#pragma unroll
        for (int k8 = 0; k8 < 8; ++k8) { const int kt = hf * 8 + k8;
            f32x4 a = (f32x4){0.f, 0.f, 0.f, 0.f}; a = mfma16(kfrag(Kt, kt, 0, lr, g), qf[0], a); a = mfma16(kfrag(Kt, kt, 1, lr, g), qf[1], a);
#pragma unroll
            for (int j = 0; j < 4; ++j) { float e = __builtin_amdgcn_exp2f(a[j] * SC2 - mx); if (MASKED) e = (kt * 16 + 4 * g + j > qlim) ? 0.f : e; a[j] = e; sum += e; }
            s[k8] = a;
            if ((k8 & 3) == 3) asm volatile("" ::: "memory"); }
#pragma unroll
        for (int i = 0; i < 4; ++i) { const bf16x8 a = pack_p(s[2 * i], s[2 * i + 1]);
#pragma unroll
            for (int dt = 0; dt < 4; ++dt) o[dt] = mfma16(a, vfrag<VPB>(Vt, dt, 128 * hf + 32 * i, lr, g), o[dt]);
            if (i & 1) asm volatile("" ::: "memory"); }
    }
    sum += __shfl_xor(sum, 16); sum += __shfl_xor(sum, 32);
    sum_out = sum;
}

template <int VPB, bool MASKED = false>
__device__ __forceinline__ void kv_tile2(const LAS unsigned char* Kt, const LAS unsigned char* Vt, const bf16x8 (&qa)[2], const bf16x8 (&qb)[2], float mx, int lr, int g,
                                         float& suma_out, float& sumb_out, f32x4 (&oa)[4], f32x4 (&ob)[4], int qlima = 4096, int qlimb = 4096) {
    float suma = 0.f, sumb = 0.f;
#pragma unroll
    for (int dt = 0; dt < 4; ++dt) { oa[dt] = (f32x4){0.f, 0.f, 0.f, 0.f}; ob[dt] = (f32x4){0.f, 0.f, 0.f, 0.f}; }
#pragma unroll
    for (int q4 = 0; q4 < 4; ++q4) {
        f32x4 sa[4], sb[4];
#pragma unroll
        for (int k4 = 0; k4 < 4; ++k4) { const int kt = q4 * 4 + k4;
            const bf16x8 k0 = kfrag(Kt, kt, 0, lr, g), k1 = kfrag(Kt, kt, 1, lr, g);
            f32x4 a = (f32x4){0.f, 0.f, 0.f, 0.f}, b = (f32x4){0.f, 0.f, 0.f, 0.f};
            a = mfma16(k0, qa[0], a); b = mfma16(k0, qb[0], b); a = mfma16(k1, qa[1], a); b = mfma16(k1, qb[1], b);
#pragma unroll
            for (int j = 0; j < 4; ++j) { float ea = __builtin_amdgcn_exp2f(a[j] * SC2 - mx), eb = __builtin_amdgcn_exp2f(b[j] * SC2 - mx);
                if (MASKED) { ea = (kt * 16 + 4 * g + j > qlima) ? 0.f : ea; eb = (kt * 16 + 4 * g + j > qlimb) ? 0.f : eb; }
                a[j] = ea; b[j] = eb; suma += ea; sumb += eb; }
            sa[k4] = a; sb[k4] = b; }
        asm volatile("" ::: "memory");
#pragma unroll
        for (int i = 0; i < 2; ++i) { const bf16x8 pa = pack_p(sa[2 * i], sa[2 * i + 1]), pb = pack_p(sb[2 * i], sb[2 * i + 1]);
#pragma unroll
            for (int dt = 0; dt < 4; ++dt) { const bf16x8 vf = vfrag<VPB>(Vt, dt, 64 * q4 + 32 * i, lr, g); oa[dt] = mfma16(pa, vf, oa[dt]); ob[dt] = mfma16(pb, vf, ob[dt]); } }
        asm volatile("" ::: "memory");
    }
    suma += __shfl_xor(suma, 16); suma += __shfl_xor(suma, 32); sumb += __shfl_xor(sumb, 16); sumb += __shfl_xor(sumb, 32);
    suma_out = suma; sumb_out = sumb;
}

__device__ __forceinline__ void mem_unit(LAS unsigned char* lds, const bf16_t* QKV, const bf16_t* MEMKV, const bf16_t* MEMVT, bf16_t* O, const float* gq, const float* gk, int b, int h, int qc, int tid) {
    constexpr int VPB = 256 * 2 + 16;
    LAS unsigned char* Kt = lds; LAS unsigned char* Vt = lds + 256 * KPB;
    const int lane = tid & 63, w = tid >> 6, lr = lane & 15, g = lane >> 4;
    LAS unsigned char* oscr = lds + 77824 + w * 2560; LAS float* rinv = (LAS float*)(oscr + 2304);
    float mx; { float a = fabsf(gq[lane]), c = fabsf(gk[lane]);
#pragma unroll
        for (int o_ = 1; o_ < 64; o_ <<= 1) { a = fmaxf(a, __shfl_xor(a, o_)); c = fmaxf(c, __shfl_xor(c, o_)); }
        mx = 64.0f * a * c * SC2; }
    stage_k<256>(Kt, MEMKV + (size_t)(b * MEML) * 512 + h * 64, 512, tid);
    stage_vt<256>(Vt, MEMVT + (size_t)((b * 4 + h) * 64) * MEML, MEML, tid);
    __syncthreads();
    LAS float* rinv2 = rinv + 16;
    for (int pass = 0; pass < 2; pass += 2) {
        asm volatile("" ::: "memory");
        const size_t row0 = (size_t)b * S + qc * 256 + pass * 128 + 16 * w, row1 = row0 + 128;
        bf16x8 qa[2], qb[2]; load_qfrag(qa, QKV + (row0 + lr) * QKVW + C_MEQ + h * 64, g); load_qfrag(qb, QKV + (row1 + lr) * QKVW + C_MEQ + h * 64, g);
        float suma, sumb; f32x4 oa[4], ob[4];
        kv_tile2<VPB>(Kt, Vt, qa, qb, mx, lr, g, suma, sumb, oa, ob);
        if (g == 0) { rinv[lr] = 1.0f / suma; rinv2[lr] = 1.0f / sumb; }
        LDS_WAIT();
#pragma unroll
        for (int j = 0; j < 4; ++j) { const float iva = rinv[4 * g + j], ivb = rinv2[4 * g + j];
#pragma unroll
            for (int dt = 0; dt < 4; ++dt) { oa[dt][j] *= iva; ob[dt][j] *= ivb; } }
        store_o16(oscr, oa, O + row0 * DM + 768 + h * 64, lane);
        store_o16(oscr, ob, O + row1 * DM + 768 + h * 64, lane);
    }
    __syncthreads();
}

__device__ __forceinline__ void kv_write(LAS unsigned char* oscr, LAS int* rowid, const f32x4 (&o)[4], float sum, float mx, int pid, bf16_t* PO, float* PML, int lane) {
    const int lr = lane & 15, g = lane >> 4;
    if (g == 0) { rowid[lr] = pid; if (pid >= 0) { PML[(size_t)pid * 2] = mx; PML[(size_t)pid * 2 + 1] = sum; } }
#pragma unroll
    for (int dt = 0; dt < 4; ++dt)
#pragma unroll
        for (int j = 0; j < 4; ++j) *(LAS unsigned short*)(oscr + (4 * g + j) * 144 + (16 * dt + lr) * 2) = (unsigned short)(cvt_pk_bf16(o[dt][j], 0.f) & 0xffffu);
    LDS_WAIT();
#pragma unroll
    for (int c = 0; c < 2; ++c) { const int idx = lane + 64 * c, row = idx >> 3, ch = idx & 7; const int rp = rowid[row];
        const u32x4 v = *(const LAS u32x4*)(oscr + row * 144 + ch * 16);
        if (rp >= 0) __builtin_nontemporal_store(v, (u32x4*)(PO + (size_t)rp * 64 + ch * 8)); }
    LDS_WAIT();
}

__device__ __forceinline__ void moba_kv_unit(LAS unsigned char* lds, const bf16_t* QKV, const bf16_t* MOVT, const unsigned* SEL, bf16_t* PO, float* PML, const float* gq, const float* gk, int b, int h, int n, int tid) {
    constexpr int VPB = 256 * 2 + 16;
    LAS unsigned char* Kt = lds; LAS unsigned char* Vt = lds + 256 * KPB;
    LAS unsigned short* list = (LAS unsigned short*)(lds + 74752);
    LAS int* cntp = (LAS int*)(lds + 90624);
    const int lane = tid & 63, w = tid >> 6, lr = lane & 15, g = lane >> 4;
    LAS unsigned char* oscr = lds + 94208 + w * 2560;
    LAS int* rowid = (LAS int*)(oscr + 2304);
    const size_t rowbase = (size_t)b * S; const int bh = b * 6 + h;
    float mx; { float a = fabsf(gq[lane]), c = fabsf(gk[lane]);
#pragma unroll
        for (int o_ = 1; o_ < 64; o_ <<= 1) { a = fmaxf(a, __shfl_xor(a, o_)); c = fmaxf(c, __shfl_xor(c, o_)); }
        mx = 64.0f * a * c * SC2; }
    stage_k<256>(Kt, QKV + (rowbase + (size_t)n * 256) * QKVW + C_MOK + h * 64, QKVW, tid);
    stage_vt<256>(Vt, MOVT + ((size_t)bh * 64) * S + (size_t)n * 256, S, tid);
    if (tid == 0) *cntp = 0;
    __syncthreads();
    { const unsigned* selrow = SEL + (size_t)bh * S;
      for (int base = (n + 1) * 256 + w * 64; base < S; base += 512) {
          const int sq = base + lane; const unsigned sv = selrow[sq];
          int slot = -1; if ((sv & 255u) == (unsigned)n) slot = 0; else if (((sv >> 8) & 255u) == (unsigned)n) slot = 1; else if (((sv >> 16) & 255u) == (unsigned)n) slot = 2;
          const bool f = slot >= 0; const unsigned long long mk = __ballot(f);
          int pos0 = 0; if (lane == 0 && mk != 0ull) pos0 = atomicAdd((int*)cntp, (int)__popcll(mk));
          pos0 = __shfl(pos0, 0);
          if (f) list[pos0 + __popcll(mk & ((1ull << lane) - 1ull))] = (unsigned short)(sq | (slot << 13)); } }
    __syncthreads();
    const int cnt = *cntp; const int total = 16 + ((cnt + 15) >> 4);
    const bf16_t* Qb = QKV + rowbase * QKVW + C_MOQ + h * 64;
    { const int sqa = n * 256 + 16 * w + lr, sqb = sqa + 128;
      bf16x8 qa[2], qb[2]; load_qfrag(qa, Qb + (size_t)sqa * QKVW, g); load_qfrag(qb, Qb + (size_t)sqb * QKVW, g);
      float suma, sumb; f32x4 oa[4], ob[4];
      kv_tile2<VPB, true>(Kt, Vt, qa, qb, mx, lr, g, suma, sumb, oa, ob, 16 * w + lr, 16 * w + 128 + lr);
      kv_write(oscr, rowid, oa, suma, mx, ((bh * S + sqa) << 2) + 3, PO, PML, lane);
      kv_write(oscr, rowid, ob, sumb, mx, ((bh * S + sqb) << 2) + 3, PO, PML, lane); }
#define KV_PAIR_FETCH(T_, ENTA_, ENTB_, VA_, VB_, QA_, QB_) do { const int ea_ = 16 * ((T_) - 16) + lr, eb_ = ea_ + 128; VA_ = ea_ < cnt; VB_ = eb_ < cnt; \
        ENTA_ = VA_ ? (unsigned)list[ea_] : 0u; ENTB_ = VB_ ? (unsigned)list[eb_] : 0u; \
        load_qfrag(QA_, Qb + (size_t)(VA_ ? (int)(ENTA_ & 8191u) : n * 256) * QKVW, g); load_qfrag(QB_, Qb + (size_t)(VB_ ? (int)(ENTB_ & 8191u) : n * 256) * QKVW, g); } while (0)
    unsigned enta = 0u, entb = 0u; bool va = false, vb = false; bf16x8 qa[2] = {}, qb[2] = {};
    if (16 + w < total) KV_PAIR_FETCH(16 + w, enta, entb, va, vb, qa, qb);
    for (int tile = 16 + w; tile < total; tile += 16) {
        unsigned entan = 0u, entbn = 0u; bool van = false, vbn = false; bf16x8 qan[2] = {}, qbn[2] = {};
        if (tile + 16 < total) KV_PAIR_FETCH(tile + 16, entan, entbn, van, vbn, qan, qbn);
        float suma, sumb; f32x4 oa[4], ob[4];
        kv_tile2<VPB>(Kt, Vt, qa, qb, mx, lr, g, suma, sumb, oa, ob);
        kv_write(oscr, rowid, oa, suma, mx, va ? (((bh * S + (int)(enta & 8191u)) << 2) + (int)(enta >> 13)) : -1, PO, PML, lane);
        kv_write(oscr, rowid, ob, sumb, mx, vb ? (((bh * S + (int)(entb & 8191u)) << 2) + (int)(entb >> 13)) : -1, PO, PML, lane);
        qa[0] = qan[0]; qa[1] = qan[1]; qb[0] = qbn[0]; qb[1] = qbn[1]; enta = entan; entb = entbn; va = van; vb = vbn;
    }
#undef KV_PAIR_FETCH
    __syncthreads();
}

__device__ __forceinline__ void moba_combine(const bf16_t* PO, const float* PML, bf16_t* O, int item) {
    const int ch = item & 7, qid = item >> 3;
    const int bh = qid >> 13, sq = qid & 8191, b = bh / 6, h = bh - b * 6, jb = sq >> 8;
    const int np = jb < 3 ? jb : 3;
    const float2* ml = (const float2*)PML + (size_t)qid * 4;
    const float2 own = ml[3]; float2 pr[3]; float mxx = own.x;
#pragma unroll
    for (int c = 0; c < 3; ++c) { pr[c] = (c < np) ? ml[c] : make_float2(-INFINITY, 0.f); mxx = fmaxf(mxx, pr[c].x); }
    float num[8], den;
    { const float wgt = __builtin_amdgcn_exp2f(own.x - mxx); den = wgt * own.y; const u32x4 v = *(const u32x4*)(PO + ((size_t)qid * 4 + 3) * 64 + ch * 8);
      num[0] = wgt * bf_lo(v.x); num[1] = wgt * bf_hi(v.x); num[2] = wgt * bf_lo(v.y); num[3] = wgt * bf_hi(v.y); num[4] = wgt * bf_lo(v.z); num[5] = wgt * bf_hi(v.z); num[6] = wgt * bf_lo(v.w); num[7] = wgt * bf_hi(v.w); }
#pragma unroll
    for (int c = 0; c < 3; ++c) if (c < np) { const float wgt = __builtin_amdgcn_exp2f(pr[c].x - mxx); den += wgt * pr[c].y; const u32x4 v = *(const u32x4*)(PO + ((size_t)qid * 4 + c) * 64 + ch * 8);
        num[0] += wgt * bf_lo(v.x); num[1] += wgt * bf_hi(v.x); num[2] += wgt * bf_lo(v.y); num[3] += wgt * bf_hi(v.y); num[4] += wgt * bf_lo(v.z); num[5] += wgt * bf_hi(v.z); num[6] += wgt * bf_lo(v.w); num[7] += wgt * bf_hi(v.w); }
    const float inv = 1.0f / den;
    u32x4 wv; wv.x = cvt_pk_bf16(num[0] * inv, num[1] * inv); wv.y = cvt_pk_bf16(num[2] * inv, num[3] * inv); wv.z = cvt_pk_bf16(num[4] * inv, num[5] * inv); wv.w = cvt_pk_bf16(num[6] * inv, num[7] * inv);
    *(u32x4*)(O + ((size_t)b * S + sq) * DM + 384 + h * 64 + ch * 8) = wv;
}

#define XB_TMO      128
#define XB_XCNT(j)  (256  + 64 * (j))
#define XB_XSUB(j)  (1280 + 64 * (j))
#define XB_XGEN(j)  (2304 + 64 * (j))
#define XB_TOP      3328
#define XB_TOPGEN   3392
#define XCD_BAR_WORDS 3456
#define XB_SPIN_CAP (1u << 18)

__device__ __forceinline__ unsigned xb_ld(unsigned* p)              { return __hip_atomic_load(p, __ATOMIC_RELAXED, __HIP_MEMORY_SCOPE_AGENT); }
__device__ __forceinline__ unsigned xb_add(unsigned* p, unsigned v) { return __hip_atomic_fetch_add(p, v, __ATOMIC_RELAXED, __HIP_MEMORY_SCOPE_AGENT); }
__device__ __forceinline__ unsigned xb_xcc_id() { return (unsigned)__builtin_amdgcn_s_getreg((3 << 11) | 20) & 0xFu; }
#define XB_SPIN(cond, bar) do { unsigned _sp = 0; while (cond) { __builtin_amdgcn_s_sleep(1); \
    if ((++_sp & 255u) == 0u) { if (xb_ld(&(bar)[XB_TMO])) break; if (_sp > XB_SPIN_CAP) { atomicAdd(&(bar)[XB_TMO], 1u); break; } } } } while (0)

struct XcdBarrier {
    unsigned* bar; unsigned x;
    volatile LAS unsigned* st;
};

__device__ __forceinline__ XcdBarrier xcd_barrier_post(unsigned* bar, volatile LAS unsigned* st) {
    XcdBarrier b; b.bar = bar; b.x = xb_xcc_id(); b.st = st;
    if (threadIdx.x == 0) (void)xb_add(&bar[XB_XCNT(b.x)], 1u);
    return b;
}
__device__ __forceinline__ void xcd_barrier_complete(unsigned* bar, unsigned x, unsigned& nloc, unsigned& nx) {
    const unsigned G = gridDim.x * gridDim.y * gridDim.z;
    unsigned sum, cnt, mine, sp = 0u;
    for (;;) {
        sum = 0u; cnt = 0u; mine = 0u;
#pragma unroll
        for (unsigned j = 0; j < 16; ++j) { const unsigned c = xb_ld(&bar[XB_XCNT(j)]); sum += c; cnt += (c > 0u) ? 1u : 0u; mine = (j == x) ? c : mine; }
        if (sum == G) break;
        __builtin_amdgcn_s_sleep(1);
        if ((++sp & 255u) == 0u) { if (xb_ld(&bar[XB_TMO])) break; if (sp > XB_SPIN_CAP) { atomicAdd(&bar[XB_TMO], 1u); break; } }
    }
    nloc = mine > 0u ? mine : 1u; nx = cnt > 0u ? cnt : 1u;
}

__device__ __forceinline__ void xcd_barrier(const XcdBarrier& b) {
    asm volatile("s_waitcnt vmcnt(0)" ::: "memory");
    __syncthreads();
    if (threadIdx.x == 0) {
        unsigned* bar = b.bar;
        __builtin_amdgcn_s_waitcnt(0);
        unsigned nloc = b.st[0], nx = b.st[1];
        if (nloc == 0u) { xcd_barrier_complete(bar, b.x, nloc, nx); b.st[0] = nloc; b.st[1] = nx; }
        const unsigned old = xb_add(&bar[XB_XSUB(b.x)], 1u);
        const unsigned gen = old / nloc;
        if (old + 1u == (gen + 1u) * nloc) {
            __builtin_amdgcn_fence(__ATOMIC_RELEASE, "agent");
            asm volatile("s_waitcnt vmcnt(0)" ::: "memory");
            const unsigned og = xb_add(&bar[XB_TOP], 1u);
            const unsigned tg = og / nx;
            if (og + 1u == (tg + 1u) * nx) xb_add(&bar[XB_TOPGEN], 1u);
            else XB_SPIN(xb_ld(&bar[XB_TOPGEN]) == tg, bar);
            __builtin_amdgcn_fence(__ATOMIC_ACQUIRE, "agent");
            xb_add(&bar[XB_XGEN(b.x)], 1u);
            asm volatile("s_waitcnt vmcnt(0)" ::: "memory");
        } else {
            XB_SPIN(xb_ld(&bar[XB_XGEN(b.x)]) == gen, bar);
            __builtin_amdgcn_fence(__ATOMIC_ACQUIRE, "agent");
            asm volatile("s_waitcnt vmcnt(0)" ::: "memory");
        }
    }
    __syncthreads();
}

#define GRID_SYNC() xcd_barrier(xbar)
#define GRID_SYNC_CG() do { asm volatile("s_waitcnt vmcnt(0) lgkmcnt(0)" ::: "memory"); __syncthreads(); grid.sync(); if (wave == 0) { __builtin_amdgcn_fence(__ATOMIC_ACQUIRE, "agent"); asm volatile("s_waitcnt vmcnt(0)" ::: "memory"); } __syncthreads(); } while (0)
#define STAGGER(ticks_per_group) do { const unsigned grp_ = (unsigned)(bx >> 3) & 3u; if (grp_ != 0u) { if (tid == 0) { const unsigned long long t0_ = __builtin_amdgcn_s_memrealtime(); \
    while (__builtin_amdgcn_s_memrealtime() - t0_ < (unsigned long long)(grp_ * (ticks_per_group))) __builtin_amdgcn_s_sleep(16); } __syncthreads(); } } while (0)
__global__ void __launch_bounds__(512, 2) hybrid_fwd(Params p) {
    extern __shared__ __attribute__((aligned(16))) unsigned char lds_raw[];
    LAS unsigned char* lds = (LAS unsigned char*)lds_raw;
    cg::grid_group grid = cg::this_grid();
    const int tid = threadIdx.x, lane = tid & 63, wave = __builtin_amdgcn_readfirstlane(tid >> 6);
    const int G = gridDim.x, bx = blockIdx.x;
    unsigned char* ws = p.ws;
    { volatile LAS unsigned* stw = (volatile LAS unsigned*)(lds + LDS_BYTES - 32); if (tid < 4) stw[tid] = 0u; }
    __syncthreads();
    const XcdBarrier xbar = xcd_barrier_post((unsigned*)(ws + WS_BAR), (volatile LAS unsigned*)(lds + LDS_BYTES - 32));
    const float* x = p.in[0];
    bf16_t* XN = (bf16_t*)(ws + WS_XN); bf16_t* QKV = (bf16_t*)(ws + WS_QKV); bf16_t* GATES = (bf16_t*)(ws + WS_GATES);
    bf16_t* MEMN = (bf16_t*)(ws + WS_MEMN); bf16_t* MEMKV = (bf16_t*)(ws + WS_MEMKV); bf16_t* MEMVT = (bf16_t*)(ws + WS_MEMVT);
    bf16_t* SBVT = (bf16_t*)(ws + WS_SBVT); bf16_t* MOVT = (bf16_t*)(ws + WS_MOVT);
    float* SS = (float*)(ws + WS_SS); float* KMEAN = (float*)(ws + WS_KMEAN); float2* ROPE = (float2*)(ws + WS_ROPE);
    unsigned* CTL = (unsigned*)(ws + WS_CTL);
    bf16_t* Win_t = (bf16_t*)(ws + WS_WIN); bf16_t* Wfin_t = (bf16_t*)(ws + WS_WFIN); bf16_t* Wfdn_t = (bf16_t*)(ws + WS_WFDN); bf16_t* Wout_t = (bf16_t*)(ws + WS_WOUT);
    bf16_t* Wupsb_t = (bf16_t*)(ws + WS_WUPSB); bf16_t* Wupmo_t = (bf16_t*)(ws + WS_WUPMO); bf16_t* Wupme_t = (bf16_t*)(ws + WS_WUPME); bf16_t* Wmemkv_t = (bf16_t*)(ws + WS_WMEMKV);
    bf16_t* OB = XN; bf16_t* X1B = XN; bf16_t* MIX = QKV; bf16_t* HB = QKV;

#ifdef TS_PHASE
    unsigned long long ts0 = __builtin_amdgcn_s_memrealtime(), tsave = 0;
    int ts_k = 0;
#define TS_MARK() do { if (ts_k == TS_PHASE) tsave = __builtin_amdgcn_s_memrealtime() - ts0; ++ts_k; } while (0)
#else
#define TS_MARK() do {} while (0)
#endif
#if PHMASK & 1
#ifndef P0REPS
#define P0REPS 1
#endif
    for (int rep0 = 0; rep0 < P0REPS; ++rep0) {
        LAS float* scr = (LAS float*)(lds + wave * 16384);
        const int gw = bx * 8 + wave, NGW = G * 8;
        constexpr int I_IN = 16 * 176, I_FIN = 16 * 176, I_FDN = 44 * 32, I_OUT = 16 * 32, I_USB = 6 * 32, I_UMO = 6 * 32, I_UME = 4 * 32, I_MKV = 16 * 16;
        constexpr int NITEMS = I_IN + I_FIN + I_FDN + I_OUT + I_USB + I_UMO + I_UME + I_MKV;
        for (int it = gw; it < NITEMS; it += NGW) {
            int r = it;
            if (r < I_IN) { p0_transpose_item<0>(p.in[5], 1024, INW, Win_t, scr, r, lane, nullptr); continue; } r -= I_IN;
            if (r < I_FIN) { p0_transpose_item<1>(p.in[15], 1024, INW, Wfin_t, scr, r, lane, p.in[4]); continue; } r -= I_FIN;
            if (r < I_FDN) { p0_transpose_item<0>(p.in[16], DFF, 1024, Wfdn_t, scr, r, lane, nullptr); continue; } r -= I_FDN;
            if (r < I_OUT) { p0_transpose_item<0>(p.in[14], 1024, 1024, Wout_t, scr, r, lane, nullptr); continue; } r -= I_OUT;
            if (r < I_USB) { p0_transpose_item<0>(p.in[11], 384, 1024, Wupsb_t, scr, r, lane, nullptr); continue; } r -= I_USB;
            if (r < I_UMO) { p0_transpose_item<0>(p.in[12], 384, 1024, Wupmo_t, scr, r, lane, nullptr); continue; } r -= I_UMO;
            if (r < I_UME) { p0_transpose_item<0>(p.in[13], 256, 1024, Wupme_t, scr, r, lane, nullptr); continue; } r -= I_UME;
            p0_transpose_item<0>(p.in[6], 1024, 512, Wmemkv_t, scr, r, lane, nullptr);
        }
        for (int m = gw; m < M; m += NGW) rms_row_to_bf16(x + (size_t)m * DM, p.in[2], XN + (size_t)m * DM, lane);
        for (int m = gw; m < NB * MEML; m += NGW) rms_row_to_bf16(p.in[1] + (size_t)m * DM, p.in[3], MEMN + (size_t)m * DM, lane);
        for (int i = bx * 512 + tid; i < S * 32; i += G * 512) rope_entry(i, ROPE);
        for (int i = bx * 512 + tid; i < M; i += G * 512) SS[i] = 0.f;
        if (bx == 0 && tid < 8) CTL[tid] = 0u;
    }
    if (p.ws == nullptr) { GRID_SYNC_CG(); }
    GRID_SYNC(); TS_MARK();
#ifdef XSEAMS
    for (int xs = 0; xs < XSEAMS; ++xs) { GRID_SYNC(); }
#endif

#endif
#if PHMASK & 2
    {
        pg8::Gemm g{XN, Win_t, M, INW, 1024, 1024}; pg8::StaticOrder So; So.init(M, INW, G, bx, WGM_WIDE);
        pg8::EpiProj E{QKV, GATES};
#ifdef STAG1
        STAGGER(STAG1);
#endif
#ifndef P1REPS
#define P1REPS 1
#endif
        pg8::gemm_phase<pg8::EpiProj, pg8::StaticOrder, true, true>(lds, g, So, E);
#if P1REPS == 2
        pg8::gemm_phase<pg8::EpiProj, pg8::StaticOrder, true, true>(lds, g, So, E);
#endif
    }
    GRID_SYNC(); TS_MARK();

#endif
#if PHMASK & 4
    {
        constexpr int N_A = 768, N_B = 768, N_C = 512, N_D = 16, N_E = 768, N_F = 768, N_G = 16;
        constexpr int NIT = N_A + N_B + N_C + N_D + N_E + N_F + N_G;
#ifdef P1BHN
        for (int it = bx; it < N_A + N_B + N_C; it += G) { int r = it;
            if (r < N_A + N_B) { const bool isk = r >= N_A; if (isk) r -= N_A; const int hh = r % 6, blk = (r / 6) % 32, bb = r / 192;
                head_norm_item(QKV + ((size_t)bb * S + blk * 256) * QKVW + (isk ? C_MOK : C_MOQ) + hh * 64, QKVW, nullptr, nullptr, nullptr, (LAS float*)lds, tid); }
            else { r -= N_A + N_B; const int hh = r % 4, blk = (r / 4) % 32, bb = r / 128;
                head_norm_item(QKV + ((size_t)bb * S + blk * 256) * QKVW + C_MEQ + hh * 64, QKVW, nullptr, nullptr, nullptr, (LAS float*)lds, tid); } }
        __syncthreads();
#endif
        pg8::Gemm g2{MEMN, Wmemkv_t, NB * MEML, 512, 1024, 1024}; pg8::StaticOrder S2; S2.init(NB * MEML, 512, G, bx);
        pg8::EpiPlain E2{MEMKV, 512};
        pg8::gemm_phase<pg8::EpiPlain, pg8::StaticOrder, true, true>(lds, g2, S2, E2);
        for (int i = 0; ; ++i) {
            pg8::Unit uu; if (!S2.next(i, uu)) break;
            for (int hh = 0; hh < 4; ++hh) {
                if (uu.pn == 0) head_norm_item(MEMKV + (size_t)(uu.pm * MEML) * 512 + hh * 64, 512, p.in[10], nullptr, nullptr, (LAS float*)lds, tid);
                else transpose_item256(MEMKV + (size_t)(uu.pm * MEML) * 512 + 256 + hh * 64, 512, MEMVT + (size_t)((uu.pm * 4 + hh) * 64) * MEML, MEML, (LAS unsigned short*)lds, tid); }
            __syncthreads();
        }
        LAS unsigned* shu = (LAS unsigned*)(lds + LDS_BYTES - 16);
        constexpr int NQ = N_A + N_B + N_C + N_E + N_F;
        for (;;) {
            __syncthreads();
            if (tid == 0) shu[0] = atomicAdd(CTL + 7, 1u);
            __syncthreads();
            int r = (int)shu[0];
            if (r >= NQ) break;
            if (r < N_A + N_B) { const bool isk = r >= N_A; if (isk) r -= N_A; const int hh = r % 6, blk = (r / 6) % 32, bb = r / 192;
                bf16_t* base = QKV + ((size_t)bb * S + blk * 256) * QKVW + (isk ? C_MOK : C_MOQ) + hh * 64;
                head_norm_item(base, QKVW, isk ? p.in[8] : p.in[7], ROPE + (size_t)blk * 256 * 32, isk ? (KMEAN + (size_t)((bb * 6 + hh) * 32 + blk) * 64) : nullptr, (LAS float*)lds, tid); continue; }
            r -= N_A + N_B;
            if (r < N_C) { const int hh = r % 4, blk = (r / 4) % 32, bb = r / 128;
                head_norm_item(QKV + ((size_t)bb * S + blk * 256) * QKVW + C_MEQ + hh * 64, QKVW, p.in[9], nullptr, nullptr, (LAS float*)lds, tid); continue; }
            r -= N_C;
            { const bool ismo = r >= N_E; if (ismo) r -= N_E; const int hh = r % 6, blk = (r / 6) % 32, bb = r / 192;
                transpose_item256(QKV + ((size_t)bb * S + blk * 256) * QKVW + (ismo ? C_MOV : C_SBV) + hh * 64, QKVW, (ismo ? MOVT : SBVT) + ((size_t)(bb * 6 + hh) * 64) * S + (size_t)blk * 256, S, (LAS unsigned short*)lds, tid); }
        }
    }
    GRID_SYNC(); TS_MARK();

#endif
#if PHMASK & 8
    {
        unsigned* SEL = (unsigned*)(ws + WS_SEL);
        { LAS unsigned* shu = (LAS unsigned*)(lds + LDS_BYTES - 16);
          for (;;) {
              __syncthreads();
              if (tid == 0) shu[0] = atomicAdd(CTL + 6, 1u);
              __syncthreads();
              const int u = (int)shu[0];
              if (u >= 768) break;
              const int jb = 31 - u / 24, bh = u % 24; moba_select_unit(lds, QKV, KMEAN, SEL, bh / 6, bh % 6, jb, tid); } }
    }
    GRID_SYNC();
    {
        const unsigned* SEL = (const unsigned*)(ws + WS_SEL); bf16_t* PO = (bf16_t*)p.out; float* PML = p.out + 25165824 + 1048576;
        LAS unsigned* shu = (LAS unsigned*)(lds + LDS_BYTES - 16);
        constexpr int U_MO = 768, U_SB = 1536, U_ME = 512;
#ifndef UMASK
#define UMASK 7
#endif
#ifndef P2REPS
#define P2REPS 1
#endif
#ifndef R2MASK
#define R2MASK 7
#endif
        for (int rep = 0; rep < P2REPS; ++rep) {
#if UMASK & 1
        if (rep == 0 || (R2MASK & 1)) for (;;) {
            __syncthreads();
            if (tid == 0) shu[0] = atomicAdd(CTL + 3 * rep, 1u);
            __syncthreads();
            const int u = (int)shu[0];
            if (u >= U_MO) break;
            const int nb = u / 24, bh = u % 24; int t2 = tid; asm volatile("" : "+v"(t2)); moba_kv_unit(lds, QKV, MOVT, SEL, PO, PML, p.in[7], p.in[8], bh / 6, bh % 6, nb, t2);
        }
#endif
#if UMASK & 2
        if (rep == 0 || (R2MASK & 2)) for (;;) {
            __syncthreads();
            if (tid == 0) shu[0] = atomicAdd(CTL + 3 * rep + 1, 1u);
            __syncthreads();
            const int v = (int)shu[0];
            if (v >= U_SB) break;
            const int qt = 63 - v / 24, bh = v % 24; int t2 = tid; asm volatile("" : "+v"(t2)); sb_unit(lds, QKV, SBVT, OB, bh / 6, bh % 6, qt, t2);
        }
#endif
#if UMASK & 4
        if (rep == 0 || (R2MASK & 4)) for (;;) {
            __syncthreads();
            if (tid == 0) shu[0] = atomicAdd(CTL + 3 * rep + 2, 1u);
            __syncthreads();
            const int v = (int)shu[0];
            if (v >= U_ME) break;
            const int qc = v / 16, bh = v % 16; int t2 = tid; asm volatile("" : "+v"(t2)); mem_unit(lds, QKV, MEMKV, MEMVT, OB, p.in[9], p.in[10], bh / 4, bh % 4, qc, t2);
        }
#endif
        }
    }
    GRID_SYNC(); TS_MARK();
    {
        const bf16_t* PO = (const bf16_t*)p.out; const float* PML = p.out + 25165824 + 1048576;
#ifndef P2CREPS
#define P2CREPS 1
#endif
        for (int r2c = 0; r2c < P2CREPS; ++r2c)
        for (int it = bx * 512 + tid; it < 24 * S * 8; it += G * 512) moba_combine(PO, PML, OB, it);
    }
    GRID_SYNC();

#endif
#if PHMASK & 16
    {
        pg8::StaticOrder So; So.init(M, 1024, G, bx, WGM_P3);
#ifndef P3MASK
#define P3MASK 7
#endif
        if (P3MASK & 1) { pg8::Gemm g{OB, Wupsb_t, M, 1024, 384, 1024}; pg8::EpiGate<true> E{MIX, GATES, 0}; pg8::gemm_phase<pg8::EpiGate<true>, pg8::StaticOrder, true, true>(lds, g, So, E); }
        if (P3MASK & 2) { pg8::Gemm g{OB + 384, Wupmo_t, M, 1024, 384, 1024}; pg8::EpiGate<false> E{MIX, GATES, 1024}; pg8::gemm_phase<pg8::EpiGate<false>, pg8::StaticOrder, true, true>(lds, g, So, E); }
        if (P3MASK & 4) { pg8::Gemm g{OB + 768, Wupme_t, M, 1024, 256, 1024}; pg8::EpiGate<false> E{MIX, GATES, 2048}; pg8::gemm_phase<pg8::EpiGate<false>, pg8::StaticOrder, true, true>(lds, g, So, E); }
#if defined(P3REPS) && P3REPS == 2
        if (P3MASK & 1) { pg8::Gemm g{OB, Wupsb_t, M, 1024, 384, 1024}; pg8::EpiGate<true> E{MIX, GATES, 0}; pg8::gemm_phase<pg8::EpiGate<true>, pg8::StaticOrder, true, true>(lds, g, So, E); }
        if (P3MASK & 2) { pg8::Gemm g{OB + 384, Wupmo_t, M, 1024, 384, 1024}; pg8::EpiGate<false> E{MIX, GATES, 1024}; pg8::gemm_phase<pg8::EpiGate<false>, pg8::StaticOrder, true, true>(lds, g, So, E); }
        if (P3MASK & 4) { pg8::Gemm g{OB + 768, Wupme_t, M, 1024, 256, 1024}; pg8::EpiGate<false> E{MIX, GATES, 2048}; pg8::gemm_phase<pg8::EpiGate<false>, pg8::StaticOrder, true, true>(lds, g, So, E); }
#endif
    }
    GRID_SYNC(); TS_MARK();

#endif
#if PHMASK & 32
    {
        pg8::Gemm g{MIX, Wout_t, M, 1024, 1024, 1024}; pg8::StaticOrder So; So.init(M, 1024, G, bx, WGM_P4);
#ifdef P4PROBE
        { pg8::EpiPlain Ep{X1B, 1024}; pg8::gemm_phase<pg8::EpiPlain, pg8::StaticOrder, true, true>(lds, g, So, Ep); }
#endif
#ifdef P4EPROBE
        { pg8::EpiRes1 Ep{x, (float*)(ws + 216 * MiB), (bf16_t*)(ws + 344 * MiB), (float*)(ws + 410 * MiB)}; pg8::gemm_phase<pg8::EpiRes1, pg8::StaticOrder, true, true>(lds, g, So, Ep); }
#endif
        pg8::EpiRes1 E{x, p.out, X1B, SS};
        pg8::gemm_phase<pg8::EpiRes1, pg8::StaticOrder, true, true>(lds, g, So, E);
    }
    GRID_SYNC(); TS_MARK();

#endif
#if PHMASK & 64
    {
        pg8::Gemm g{X1B, Wfin_t, M, INW, 1024, 1024}; pg8::StaticOrder So; So.init(M, INW, G, bx, WGM_WIDE);
        pg8::EpiSwiGLU E{HB, SS};
#ifdef STAG5
        STAGGER(STAG5);
#endif
#ifndef P5REPS
#define P5REPS 1
#endif
        pg8::gemm_phase<pg8::EpiSwiGLU, pg8::StaticOrder, true, true>(lds, g, So, E);
#if P5REPS == 2
        pg8::gemm_phase<pg8::EpiSwiGLU, pg8::StaticOrder, true, true>(lds, g, So, E);
#endif
    }
    GRID_SYNC(); TS_MARK();

#endif
#if PHMASK & 128
    {
        pg8::Gemm g{HB, Wfdn_t, M, 1024, DFF, DFF}; pg8::StaticOrder So; So.init(M, 1024, G, bx, WGM_P6);
#ifdef P6PROBE
        { pg8::EpiPlain Ep{X1B, 1024}; pg8::gemm_phase<pg8::EpiPlain, pg8::StaticOrder, true, true>(lds, g, So, Ep); }
#endif
#ifdef P6EPROBE
        { pg8::EpiRes2 Ep{(float*)(ws + 330 * MiB), p.out}; pg8::gemm_phase<pg8::EpiRes2, pg8::StaticOrder, true, true>(lds, g, So, Ep); }
#endif
        pg8::EpiRes2 E{p.out, p.out};
        pg8::gemm_phase<pg8::EpiRes2, pg8::StaticOrder, true, true>(lds, g, So, E);
    }
#endif
#ifdef TS_PHASE
    GRID_SYNC();
    if (bx == 0 && tid == 0) p.out[0] = (float)tsave * 0.01f;
#endif
#ifdef DUMP_OFF
    GRID_SYNC(); TS_MARK();
    { const bf16_t* src = (const bf16_t*)(ws + (size_t)DUMP_OFF * MiB); const size_t N1 = (size_t)M * DM;
      for (size_t i = (size_t)bx * 512 + tid; i < N1; i += (size_t)G * 512) { float a = 0.f;
          for (int k = 0; k < DUMP_NK; ++k) { const unsigned v = src[i + (size_t)k * N1]; a += __uint_as_float(v << 16); }
          p.out[i] = a; } }
#endif
}

extern "C" void kernel_launch(void* const* d_in, const int* in_sizes, int n_in, void* d_out, int out_size, void* d_ws, size_t ws_size, hipStream_t stream) {
    static int grid = 0;
    if (grid == 0) {
        if (n_in != 17 || out_size != M * DM || ws_size < WS_END) { fprintf(stderr, "kernel_launch: unexpected shapes: n_in %d out %d ws %zu (need %zu)\n", n_in, out_size, ws_size, (size_t)WS_END); grid = -1; return; }
        int dev = 0, cus = 0, per_cu = 0;
        hipGetDevice(&dev); hipDeviceGetAttribute(&cus, hipDeviceAttributeMultiprocessorCount, dev);
        if (hipFuncSetAttribute((const void*)hybrid_fwd, hipFuncAttributeMaxDynamicSharedMemorySize, LDS_BYTES) != hipSuccess) { fprintf(stderr, "kernel_launch: hipFuncSetAttribute(%d B LDS) failed\n", LDS_BYTES); }
        if (hipOccupancyMaxActiveBlocksPerMultiprocessor(&per_cu, (const void*)hybrid_fwd, 512, LDS_BYTES) != hipSuccess || per_cu < 1) fprintf(stderr, "kernel_launch: occupancy query says %d blocks/CU\n", per_cu);
        (void)hipGetLastError();
        grid = cus > 0 ? cus : 256;
    }
    if (grid < 0) return;
    Params p{};
    for (int i = 0; i < 17; ++i) p.in[i] = (const float*)d_in[i];
    p.out = (float*)d_out; p.ws = (unsigned char*)d_ws;
    if (hipMemsetAsync((char*)d_ws + WS_BAR, 0, 16 * 1024, stream) != hipSuccess) { fprintf(stderr, "kernel_launch: hipMemsetAsync of the barrier words failed\n"); return; }
    void* args[] = {&p};
    hipError_t e = hipLaunchCooperativeKernel((const void*)hybrid_fwd, dim3(grid), dim3(512), args, LDS_BYTES, stream);
    if (e != hipSuccess) fprintf(stderr, "kernel_launch: cooperative launch failed: %s (grid %d)\n", hipGetErrorString(e), grid);
}
```
